# Optimizing an MI355X kernel written in HIP

```python
import jax
import jax.numpy as jnp
from jax import lax
import numpy as np

D_MODEL = 2048
BATCH = 2
SEQ = 8192
DEPTH = 4

GRID_W = 64
N_MIXERS = 2
N_NA_LAYERS = (DEPTH + N_MIXERS - 1) // N_MIXERS
N_MLA_LAYERS = DEPTH // N_MIXERS
RMS_EPS = 1e-6

NA_HEADS = 16
NA_HEAD_DIM = 128
NA_WIDTH = NA_HEADS * NA_HEAD_DIM
NA_KH_MAX = 8
NA_KW = 16

MLA_HEADS = 16
Q_LORA_RANK = 512
KV_LORA_RANK = 512
QK_NOPE_DIM = 128
QK_ROPE_DIM = 64
QK_HEAD_DIM = QK_NOPE_DIM + QK_ROPE_DIM
V_HEAD_DIM = 128
MLA_WIDTH = MLA_HEADS * V_HEAD_DIM
MLA_IN_DIM = Q_LORA_RANK + KV_LORA_RANK + QK_ROPE_DIM + MLA_WIDTH
ROPE_THETA = 10000.0
Q_BLOCK = 128

kernel_name = "hybrid_na_mla_sandwich_encoder"


def rms_norm(x, g):
    xf = x.astype(jnp.float32)
    y = xf * lax.rsqrt(jnp.mean(xf * xf, axis=-1, keepdims=True) + RMS_EPS)
    return (y * g.astype(jnp.float32)).astype(x.dtype)


def rope_tables(length):
    inv_freq = 1.0 / (ROPE_THETA ** (jnp.arange(0, QK_ROPE_DIM, 2, dtype=jnp.float32) / QK_ROPE_DIM))
    ang = jnp.arange(length, dtype=jnp.float32)[:, None] * inv_freq[None, :]
    return jnp.cos(ang), jnp.sin(ang)


def apply_rope(x, cos, sin):
    xf = x.astype(jnp.float32)
    x1, x2 = xf[..., 0::2], xf[..., 1::2]
    c, s = cos[None, :, None, :], sin[None, :, None, :]
    out = jnp.stack([x1 * c - x2 * s, x1 * s + x2 * c], axis=-1)
    return out.reshape(x.shape).astype(x.dtype)


def neighbourhood_attention(q, k, v, rpb):
    B, L, H, Dh = q.shape
    rows = L // GRID_W
    kh = min(NA_KH_MAX, rows)
    kw = NA_KW
    qg = q.reshape(B, rows, GRID_W, H, Dh)
    kg = k.reshape(B, rows, GRID_W, H, Dh)
    vg = v.reshape(B, rows, GRID_W, H, Dh)
    col = jnp.arange(GRID_W)
    col_start = jnp.clip(col - kw // 2, 0, GRID_W - kw)
    col_idx = col_start[:, None] + jnp.arange(kw)[None, :]
    dc = col_idx - col[:, None] + (kw - 1)
    scale = Dh ** -0.5

    def one_row(r):
        row_start = jnp.clip(r - kh // 2, 0, rows - kh)
        k_rows = lax.dynamic_slice_in_dim(kg, row_start, kh, axis=1)
        v_rows = lax.dynamic_slice_in_dim(vg, row_start, kh, axis=1)
        k_nb = jnp.take(k_rows, col_idx, axis=2)
        v_nb = jnp.take(v_rows, col_idx, axis=2)
        q_r = lax.dynamic_index_in_dim(qg, r, axis=1, keepdims=False)
        s = jnp.einsum('bqhd,bxqyhd->bhqxy', q_r, k_nb).astype(jnp.float32) * scale
        dr = row_start + jnp.arange(kh) - r + (NA_KH_MAX - 1)
        bias = rpb[:, dr[None, :, None], dc[:, None, :]]
        s = s + bias[None].astype(jnp.float32)
        p = jax.nn.softmax(s.reshape(B, H, GRID_W, kh * kw), axis=-1)
        p = p.reshape(B, H, GRID_W, kh, kw).astype(v.dtype)
        return jnp.einsum('bhqxy,bxqyhd->bqhd', p, v_nb)

    out = lax.map(one_row, jnp.arange(rows))
    return jnp.transpose(out, (1, 0, 2, 3, 4)).reshape(B, L, H * Dh)


def dense_attention(q, k, v, scale):
    B, L, H, Dq = q.shape
    Dv = v.shape[-1]
    nb = L // Q_BLOCK
    qb = jnp.transpose(q.reshape(B, nb, Q_BLOCK, H, Dq), (1, 0, 2, 3, 4))

    def one_block(qi):
        s = jnp.einsum('bqhd,bkhd->bhqk', qi, k).astype(jnp.float32) * scale
        p = jax.nn.softmax(s, axis=-1).astype(v.dtype)
        return jnp.einsum('bhqk,bkhd->bqhd', p, v)

    o = lax.map(one_block, qb)
    return jnp.transpose(o, (1, 0, 2, 3, 4)).reshape(B, L, H * Dv)


def na_mixer(h, w_in, rpb):
    B, L, _ = h.shape
    q, k, v, z = jnp.split(h @ w_in, 4, axis=-1)
    shp = (B, L, NA_HEADS, NA_HEAD_DIM)
    o = neighbourhood_attention(q.reshape(shp), k.reshape(shp), v.reshape(shp), rpb)
    return o, z


def mla_mixer(h, w_in, q_norm, w_q_b, kv_norm, w_kv_b):
    B, L, _ = h.shape
    splits = [Q_LORA_RANK, Q_LORA_RANK + KV_LORA_RANK, Q_LORA_RANK + KV_LORA_RANK + QK_ROPE_DIM]
    c_q, c_kv, k_rope, z = jnp.split(h @ w_in, splits, axis=-1)
    q = (rms_norm(c_q, q_norm) @ w_q_b).reshape(B, L, MLA_HEADS, QK_HEAD_DIM)
    kv = (rms_norm(c_kv, kv_norm) @ w_kv_b).reshape(B, L, MLA_HEADS, QK_NOPE_DIM + V_HEAD_DIM)
    cos, sin = rope_tables(L)
    q = jnp.concatenate([q[..., :QK_NOPE_DIM], apply_rope(q[..., QK_NOPE_DIM:], cos, sin)], axis=-1)
    k_r = apply_rope(k_rope[:, :, None, :], cos, sin)
    k = jnp.concatenate([kv[..., :QK_NOPE_DIM],
                         jnp.broadcast_to(k_r, (B, L, MLA_HEADS, QK_ROPE_DIM))], axis=-1)
    v = kv[..., QK_NOPE_DIM:]
    o = dense_attention(q, k, v, QK_HEAD_DIM ** -0.5)
    return o, z


def setup_inputs(seed: int = 0) -> dict:
    key = jax.random.key(seed)
    ks = jax.random.split(key, 13)

    def w(k, shape, fan_in):
        return jax.random.normal(k, shape, jnp.float32) * fan_in ** -0.5

    def gain(k, shape):
        return 1.0 + 0.05 * jax.random.normal(k, shape, jnp.float32)

    return {
        "x": jax.random.normal(ks[0], (BATCH, SEQ, D_MODEL), jnp.float32),
        "norm_pre": gain(ks[1], (DEPTH, D_MODEL)),
        "norm_post": gain(ks[2], (DEPTH, D_MODEL)),
        "na_w_in": w(ks[3], (N_NA_LAYERS, D_MODEL, 4 * NA_WIDTH), D_MODEL),
        "na_rpb": 0.1 * jax.random.normal(ks[4], (N_NA_LAYERS, NA_HEADS, 2 * NA_KH_MAX - 1, 2 * NA_KW - 1), jnp.float32),
        "na_w_out": w(ks[5], (N_NA_LAYERS, NA_WIDTH, D_MODEL), NA_WIDTH),
        "mla_w_in": w(ks[6], (N_MLA_LAYERS, D_MODEL, MLA_IN_DIM), D_MODEL),
        "mla_q_norm": gain(ks[7], (N_MLA_LAYERS, Q_LORA_RANK)),
        "mla_w_q_b": w(ks[8], (N_MLA_LAYERS, Q_LORA_RANK, MLA_HEADS * QK_HEAD_DIM), Q_LORA_RANK),
        "mla_kv_norm": gain(ks[9], (N_MLA_LAYERS, KV_LORA_RANK)),
        "mla_w_kv_b": w(ks[10], (N_MLA_LAYERS, KV_LORA_RANK, MLA_HEADS * (QK_NOPE_DIM + V_HEAD_DIM)), KV_LORA_RANK),
        "mla_w_out": w(ks[11], (N_MLA_LAYERS, MLA_WIDTH, D_MODEL), MLA_WIDTH),
    }


def reference(x, norm_pre, norm_post, na_w_in, na_rpb, na_w_out, mla_w_in, mla_q_norm,
              mla_w_q_b, mla_kv_norm, mla_w_kv_b, mla_w_out):
    for i in range(DEPTH):
        h = rms_norm(x, norm_pre[i])
        j = i // N_MIXERS
        if i % N_MIXERS == 0:
            o, z = na_mixer(h, na_w_in[j], na_rpb[j])
            w_out = na_w_out[j]
        else:
            o, z = mla_mixer(h, mla_w_in[j], mla_q_norm[j], mla_w_q_b[j], mla_kv_norm[j], mla_w_kv_b[j])
            w_out = mla_w_out[j]
        y = (o * jax.nn.silu(z)) @ w_out
        x = x + rms_norm(y, norm_post[i])
    return x
```

```cpp
#include <hip/hip_runtime.h>
#include <hip/hip_cooperative_groups.h>
#include <cstdio>
#include <cstdint>
namespace cg = cooperative_groups;
__device__ __forceinline__ int opaque_tid() { int t = threadIdx.x; asm volatile("" : "+v"(t)); return t; }
namespace pg8 {
#define PG8_LAS __attribute__((address_space(3)))
typedef unsigned short bf16_t;
typedef short bf16x8 __attribute__((ext_vector_type(8)));
typedef float f32x4 __attribute__((ext_vector_type(4)));
typedef unsigned u32x4 __attribute__((ext_vector_type(4)));
constexpr int BM = 256, BK = 64, HALF = 128, HTB = HALF * BK * 2  , STAGE_BYTES = 8 * HTB, NXCD = 8, WGM = 8;

__host__ __device__ __forceinline__ int lds_byte(int r, int c) { const int st = (r >> 4) * 2 + (c >> 5), rr = r & 15, cc = c & 31, ob = rr * 64 + cc * 2; return st * 1024 + (ob ^ (((ob >> 9) & 1) << 5)); }
__host__ __device__ __forceinline__ void stage_rc(int b, int& R, int& C) { const int st = b / 1024, sb = b % 1024, swz = sb ^ (((sb >> 9) & 1) << 5); R = (st >> 1) * 16 + swz / 64; C = (st & 1) * 32 + (swz % 64) / 2; }
__host__ __device__ __forceinline__ int perm32(int rho) { const int n = rho >> 4, i = rho & 15; return 8 * (i >> 2) + 4 * n + (i & 3); }

struct Unit { int pm, pn; };
struct Gemm { const bf16_t* A; const bf16_t* Bt; int M, N, K; };

struct StaticOrder {
    int nM, nN, nwg, G, c;
    __host__ __device__ void init(int M, int N, int G_, int c_) { nM = M / BM; nN = N / BM; nwg = nM * nN; G = G_; c = c_; }
    __host__ __device__ bool next(int i, Unit& u) const {
        const long L = (long)i * G + c; if (L >= nwg) return false;
        int wgid = (int)L; { const int q = nwg / NXCD, r = nwg % NXCD, xcd = wgid % NXCD, off = wgid / NXCD; wgid = (xcd < r ? xcd * (q + 1) : r * (q + 1) + (xcd - r) * q) + off; }
        const int nig = WGM * nN, gid = wgid / nig, fm = gid * WGM, gsz = (nM - fm) < WGM ? (nM - fm) : WGM;
        u.pm = fm + ((wgid % nig) % gsz); u.pn = (wgid % nig) / gsz; return true;
    }
    __device__ __forceinline__ void a_ready(const Unit&) const {}
    __device__ __forceinline__ void done(const Unit&) const {}
};

__device__ __forceinline__ unsigned cvt_pk_bf16(float lo, float hi) { unsigned r; asm volatile("v_cvt_pk_bf16_f32 %0, %1, %2" : "=v"(r) : "v"(lo), "v"(hi)); return r; }
typedef float f32x2 __attribute__((ext_vector_type(2)));
__device__ __forceinline__ f32x2 gelu_pk(f32x2 v) {
    const f32x2 av = __builtin_elementwise_abs(v), d = av * 0.2316418882f + 1.0f;
    f32x2 t; t.x = __builtin_amdgcn_rcpf(d.x); t.y = __builtin_amdgcn_rcpf(d.y);
    f32x2 q = t * 0.5307027145f + (-0.7265760135f); q = q * t + 0.7107068705f; q = q * t + (-0.142248368f); q = q * t + 0.127414796f; q = q * t;
    const f32x2 s = (v * v) * (-0.72134752044f);
    f32x2 e; e.x = __builtin_amdgcn_exp2f(s.x); e.y = __builtin_amdgcn_exp2f(s.y);
    const f32x2 m = v * (q * e), r = v - m;
    f32x2 o; o.x = v.x < 0.f ? m.x : r.x; o.y = v.y < 0.f ? m.y : r.y; return o;
}

template <int ACT  > struct EpiBf16 {
    static constexpr bool PERM = true, AFTER_DRAIN = false; static_assert(ACT == 0 || ACT == 1, "EpiBf16: ACT is 0 (none) or 1 (gelu_pk)");
    bf16_t* O; int ldc; const float* bias; int split_cols; size_t split_stride; float scale0;
    __device__ __forceinline__ void operator()(const f32x4 (&acc)[2][2][4][2], const Unit& u, int wr, int wc, int fr, int fq) const {
        const int row0 = u.pm * BM + wr * 64 + fr; int colt = u.pn * BM; bf16_t* base = O;
        float sc = 1.f; if (split_cols) { const int t = colt / split_cols; base += (size_t)t * split_stride; colt -= t * split_cols; if (t == 0) sc = scale0; }
        const int col0 = colt + wc * 32 + 8 * fq, bcol0 = u.pn * BM + wc * 32 + 8 * fq;
        f32x4 bv[2][2];
#pragma unroll
        for (int bj = 0; bj < 2; ++bj)
#pragma unroll
            for (int n = 0; n < 2; ++n) bv[bj][n] = bias ? *(const f32x4*)(bias + bcol0 + bj * HALF + 4 * n) : (f32x4){0.f, 0.f, 0.f, 0.f};
#pragma unroll
        for (int ai = 0; ai < 2; ++ai)
#pragma unroll
            for (int m = 0; m < 4; ++m) { bf16_t* rowp = base + (size_t)(row0 + ai * HALF + m * 16) * ldc + col0;
#pragma unroll
                for (int bj = 0; bj < 2; ++bj) { f32x4 v0 = acc[ai][bj][m][0] + bv[bj][0], v1 = acc[ai][bj][m][1] + bv[bj][1];
                    if (ACT == 1) { f32x2 a = gelu_pk((f32x2){v0[0], v0[1]}), b = gelu_pk((f32x2){v0[2], v0[3]}), c = gelu_pk((f32x2){v1[0], v1[1]}), d = gelu_pk((f32x2){v1[2], v1[3]});
                        v0 = (f32x4){a.x, a.y, b.x, b.y}; v1 = (f32x4){c.x, c.y, d.x, d.y}; }
                    v0 = v0 * sc; v1 = v1 * sc; u32x4 w; w.x = cvt_pk_bf16(v0[0], v0[1]); w.y = cvt_pk_bf16(v0[2], v0[3]); w.z = cvt_pk_bf16(v1[0], v1[1]); w.w = cvt_pk_bf16(v1[2], v1[3]);
                    *(u32x4*)(rowp + bj * HALF) = w; } }
    }
};
template <class Epi, class Sched, bool ALIGN_EPI = false, bool SP2 = false>
__device__ __forceinline__ void gemm_phase(PG8_LAS unsigned char* lds, const Gemm g, const Sched& S, const Epi& E) {
    const int tid = opaque_tid(), wid = __builtin_amdgcn_readfirstlane(tid >> 6), lane = tid & 63, wr = wid >> 2, wc = wid & 3, fr = lane & 15, fq = lane >> 4;
    const int K = g.K, nt = K / BK;
    unsigned voffA[2], voffB[2];
#pragma unroll
    for (int i = 0; i < 2; ++i) { int R, C; stage_rc(tid * 16 + i * 8192, R, C); const int Rb = Epi::PERM ? ((R & ~31) + perm32(R & 31)) : R;
        voffA[i] = (unsigned)(R * BK + C) * 2u; voffB[i] = (unsigned)(Rb * BK + C) * 2u; }
    const size_t kstep = (size_t)(BK * 2);
    const size_t hstep = (size_t)HALF * K * 2;
    const size_t tstep = 2 * hstep;
    const size_t kstepA = (size_t)g.M * BK * 2;
    const size_t kstepB = (size_t)g.N * BK * 2, hstepB = (size_t)HALF * BK * 2, tstepB = 2 * hstepB;
    const unsigned ldsw = (unsigned)wid * 1024u;
    const int aoff = lds_byte(wr * 64 + fr, fq * 8), boff = lds_byte(wc * 32 + fr, fq * 8);
#define PG8_SA(b, h) (((b) * 2 + (h)) * HTB)
#define PG8_SB(b, h) ((4 + (b) * 2 + (h)) * HTB)
#define PG8_STAGE(bufoff, gbase, voff) do { _Pragma("unroll") for (int _i = 0; _i < 2; ++_i) \
        __builtin_amdgcn_global_load_lds((const unsigned*)((const char*)(gbase) + (voff)[_i]), (PG8_LAS unsigned*)(lds + (bufoff) + ldsw + _i * 8192), 16, 0, 0); } while (0)
#define PG8_LDA(dst, b, h) do { _Pragma("unroll") for (int m = 0; m < 4; ++m) _Pragma("unroll") for (int k = 0; k < 2; ++k) dst[m][k] = *(const PG8_LAS bf16x8*)(lds + PG8_SA(b, h) + aoff + m * 2048 + k * 1024); } while (0)
#define PG8_LDB(dst, b, h) do { _Pragma("unroll") for (int n = 0; n < 2; ++n) _Pragma("unroll") for (int k = 0; k < 2; ++k) dst[n][k] = *(const PG8_LAS bf16x8*)(lds + PG8_SB(b, h) + boff + n * 2048 + k * 1024); } while (0)
#define PG8_MMA(ai, bj, At, Bt) do { __builtin_amdgcn_s_setprio(1); _Pragma("unroll") for (int m = 0; m < 4; ++m) _Pragma("unroll") for (int n = 0; n < 2; ++n) _Pragma("unroll") for (int k = 0; k < 2; ++k) \
        acc[ai][bj][m][n] = __builtin_amdgcn_mfma_f32_16x16x32_bf16(Bt[n][k], At[m][k], acc[ai][bj][m][n], 0, 0, 0); __builtin_amdgcn_s_setprio(0); } while (0)
#define PG8_WAIT_V(n) asm volatile("s_waitcnt vmcnt(" #n ")" ::: "memory")
#define PG8_WAIT_L(n) asm volatile("s_waitcnt lgkmcnt(" #n ")" ::: "memory")
#define PG8_BAR __builtin_amdgcn_s_barrier()
#define PG8_SCHED __builtin_amdgcn_sched_barrier(0)
    Unit cur, nxt; int ui = 0;
    if (!S.next(0, cur)) return;
    f32x4 acc[2][2][4][2];
#pragma unroll
    for (int a = 0; a < 2; ++a)
#pragma unroll
        for (int b = 0; b < 2; ++b)
#pragma unroll
            for (int m = 0; m < 4; ++m)
#pragma unroll
                for (int n = 0; n < 2; ++n) acc[a][b][m][n] = (f32x4){0.f, 0.f, 0.f, 0.f};
    bf16x8 At[4][2], B0[2][2], B1[2][2];
    const char* cA = (const char*)g.A + (size_t)cur.pm * tstepB; const char* cB = (const char*)g.Bt + (size_t)cur.pn * tstepB;
    S.a_ready(cur);
    if constexpr (SP2) {
        PG8_STAGE(PG8_SB(0, 0), cB, voffB); PG8_STAGE(PG8_SB(0, 1), cB + hstepB, voffB); PG8_STAGE(PG8_SA(0, 0), cA, voffA); PG8_STAGE(PG8_SA(0, 1), cA + hstepB, voffA);
        if (wr == 1) PG8_BAR;
        PG8_WAIT_V(2); PG8_BAR;
        PG8_STAGE(PG8_SB(1, 0), cB + kstepB, voffB); PG8_STAGE(PG8_SA(1, 0), cA + kstepA, voffA); PG8_STAGE(PG8_SB(1, 1), cB + hstepB + kstepB, voffB);
        PG8_WAIT_V(6); PG8_BAR;
    } else {
        PG8_STAGE(PG8_SB(0, 0), cB, voffB); PG8_STAGE(PG8_SA(0, 0), cA, voffA); PG8_STAGE(PG8_SB(0, 1), cB + hstepB, voffB); PG8_STAGE(PG8_SA(0, 1), cA + hstepB, voffA);
        if (wr == 1) PG8_BAR;
        PG8_WAIT_V(4); PG8_BAR;
        PG8_STAGE(PG8_SB(1, 0), cB + kstepB, voffB); PG8_STAGE(PG8_SA(1, 0), cA + kstepA, voffA); PG8_STAGE(PG8_SB(1, 1), cB + hstepB + kstepB, voffB);
        PG8_WAIT_V(6); PG8_BAR;
    }
    for (;;) {
        const bool has_next = S.next(ui + 1, nxt);
        const char* nA = has_next ? (const char*)g.A + (size_t)nxt.pm * tstepB : cA; const char* nB = has_next ? (const char*)g.Bt + (size_t)nxt.pn * tstepB : cB;
        for (int t = 0; t < nt; t += 2) {
            const bool last = (t == nt - 2);
            const char* a1 = cA + (size_t)(t + 1) * kstepA;
            const char* a2 = last ? nA : cA + (size_t)(t + 2) * kstepA; const char* b2 = last ? nB : cB + (size_t)(t + 2) * kstepB;
            const char* a3 = a2 + kstepA; const char* b3 = b2 + kstepB;
            if (last && has_next) S.a_ready(nxt);
            if constexpr (SP2) {
            PG8_LDB(B0, 0, 0); PG8_LDB(B1, 0, 1); PG8_SCHED; PG8_LDA(At, 0, 0); PG8_STAGE(PG8_SA(1, 1), a1 + hstepB, voffA);
            PG8_WAIT_V(8); PG8_WAIT_L(0); PG8_BAR; PG8_MMA(0, 0, At, B0); PG8_MMA(0, 1, At, B1); PG8_BAR; PG8_SCHED;
            PG8_LDA(At, 0, 1); PG8_STAGE(PG8_SB(0, 0), b2, voffB); PG8_STAGE(PG8_SB(0, 1), b2 + hstepB, voffB); PG8_STAGE(PG8_SA(0, 0), a2, voffA);
            PG8_WAIT_V(8); PG8_WAIT_L(0); PG8_BAR; PG8_MMA(1, 0, At, B0); PG8_MMA(1, 1, At, B1); PG8_BAR; PG8_SCHED;
            PG8_LDB(B0, 1, 0); PG8_LDB(B1, 1, 1); PG8_SCHED; PG8_LDA(At, 1, 0); PG8_STAGE(PG8_SA(0, 1), a2 + hstepB, voffA);
            PG8_WAIT_V(8); PG8_WAIT_L(0); PG8_BAR; PG8_MMA(0, 0, At, B0); PG8_MMA(0, 1, At, B1); PG8_BAR; PG8_SCHED;
            PG8_LDA(At, 1, 1); PG8_STAGE(PG8_SB(1, 0), b3, voffB); PG8_STAGE(PG8_SB(1, 1), b3 + hstepB, voffB); PG8_STAGE(PG8_SA(1, 0), a3, voffA);
            PG8_WAIT_V(8); PG8_WAIT_L(0); PG8_BAR; PG8_MMA(1, 0, At, B0); PG8_MMA(1, 1, At, B1); PG8_BAR; PG8_SCHED;
            } else {
            PG8_LDB(B0, 0, 0); PG8_SCHED; PG8_LDA(At, 0, 0); PG8_STAGE(PG8_SA(1, 1), a1 + hstepB, voffA);
            PG8_WAIT_L(8); PG8_BAR; PG8_WAIT_L(0); PG8_MMA(0, 0, At, B0); PG8_BAR; PG8_SCHED;
            PG8_LDB(B1, 0, 1); PG8_STAGE(PG8_SB(0, 0), b2, voffB);
            PG8_BAR; PG8_WAIT_L(0); PG8_MMA(0, 1, At, B1); PG8_BAR;
            PG8_LDA(At, 0, 1); PG8_STAGE(PG8_SA(0, 0), a2, voffA);
            PG8_BAR; PG8_WAIT_L(0); PG8_MMA(1, 0, At, B0); PG8_BAR; PG8_SCHED;
            PG8_STAGE(PG8_SB(0, 1), b2 + hstepB, voffB);
            PG8_WAIT_V(6); PG8_BAR; PG8_MMA(1, 1, At, B1); PG8_BAR;
            PG8_LDB(B0, 1, 0); PG8_SCHED; PG8_LDA(At, 1, 0); PG8_STAGE(PG8_SA(0, 1), a2 + hstepB, voffA);
            PG8_WAIT_L(8); PG8_BAR; PG8_WAIT_L(0); PG8_MMA(0, 0, At, B0); PG8_BAR; PG8_SCHED;
            PG8_LDB(B1, 1, 1); PG8_STAGE(PG8_SB(1, 0), b3, voffB);
            PG8_BAR; PG8_WAIT_L(0); PG8_MMA(0, 1, At, B1); PG8_BAR;
            PG8_LDA(At, 1, 1); PG8_STAGE(PG8_SA(1, 0), a3, voffA);
            PG8_BAR; PG8_WAIT_L(0); PG8_MMA(1, 0, At, B0); PG8_BAR; PG8_SCHED;
            PG8_STAGE(PG8_SB(1, 1), b3 + hstepB, voffB);
            PG8_WAIT_V(6); PG8_BAR; PG8_MMA(1, 1, At, B1); PG8_BAR;
            }
        }
        if constexpr (ALIGN_EPI) { if (wr == 0) PG8_BAR; }
        if constexpr (!Epi::AFTER_DRAIN) { E(acc, cur, wr, wc, fr, fq); S.done(cur); }
        if (!has_next) break;
#pragma unroll
        for (int a = 0; a < 2; ++a)
#pragma unroll
            for (int b = 0; b < 2; ++b)
#pragma unroll
                for (int m = 0; m < 4; ++m)
#pragma unroll
                    for (int n = 0; n < 2; ++n) acc[a][b][m][n] = (f32x4){0.f, 0.f, 0.f, 0.f};
        cur = nxt; cA = nA; cB = nB; ++ui;
        if constexpr (ALIGN_EPI) { if (wr == 1) PG8_BAR; }
    }
    PG8_WAIT_V(0);
    if constexpr (!ALIGN_EPI) { if (wr == 0) PG8_BAR; }
    PG8_BAR;
    if constexpr (Epi::AFTER_DRAIN) { E.fused(acc, cur, wr, wc, fr, fq, lds, wid, lane); S.done(cur); }
#undef PG8_SA
#undef PG8_SB
#undef PG8_STAGE
#undef PG8_LDA
#undef PG8_LDB
#undef PG8_MMA
#undef PG8_WAIT_V
#undef PG8_WAIT_L
#undef PG8_BAR
#undef PG8_SCHED
}
}
#ifndef REP_CONV
#define REP_CONV 1
#endif
#ifndef REP_MID
#define REP_MID 1
#endif
#ifndef REP_SYNC
#define REP_SYNC 1
#endif
#ifndef REP_NA
#define REP_NA 1
#endif
#ifndef REP_MLA
#define REP_MLA 1
#endif
#ifndef REP_GEMM
#define REP_GEMM 1
#endif
#ifndef EN_GEMM
#define EN_GEMM 1
#endif
#ifndef EN_NA
#define EN_NA 1
#endif
#ifndef EN_MLA
#define EN_MLA 1
#endif
#ifndef EN_ROW
#define EN_ROW 1
#endif
#ifndef EN_PRO
#define EN_PRO 1
#endif
#ifndef EN_MID
#define EN_MID 1
#endif

constexpr int SEQ = 8192, BATCH = 2, DM = 2048, M_TOK = BATCH * SEQ, DEPTH = 4;
constexpr int NA_N = 8192, MLA_NP = 3328  , QB_N = 3072, KVB_N = 4096, LORA = 512;
constexpr float RMS_EPS = 1e-6f;
constexpr int NWAVES = 8;
#define LAS __attribute__((address_space(3)))
typedef unsigned short bf16_t;
typedef unsigned v4u __attribute__((ext_vector_type(4)));
typedef unsigned v2u __attribute__((ext_vector_type(2)));
typedef float f32x4 __attribute__((ext_vector_type(4)));

__device__ __forceinline__ float bf2f(unsigned h) { return __uint_as_float(h << 16); }
__device__ __forceinline__ unsigned f2bf(float f) { unsigned u = __float_as_uint(f); return (u + 0x7fffu + ((u >> 16) & 1u)) >> 16; }
__device__ __forceinline__ unsigned pk2(float lo, float hi) { return f2bf(lo) | (f2bf(hi) << 16); }
__device__ __forceinline__ float wave_sum(float v) {
    v += __uint_as_float(__builtin_amdgcn_mov_dpp(__float_as_uint(v), 0xB1, 0xF, 0xF, true));
    v += __uint_as_float(__builtin_amdgcn_mov_dpp(__float_as_uint(v), 0x4E, 0xF, 0xF, true));
    v += __uint_as_float(__builtin_amdgcn_mov_dpp(__float_as_uint(v), 0x141, 0xF, 0xF, true));
    v += __uint_as_float(__builtin_amdgcn_mov_dpp(__float_as_uint(v), 0x140, 0xF, 0xF, true));
    { auto rr = __builtin_amdgcn_permlane16_swap(__float_as_uint(v), __float_as_uint(v), false, false); v = __uint_as_float(rr[0]) + __uint_as_float(rr[1]); }
    { auto rr = __builtin_amdgcn_permlane32_swap(__float_as_uint(v), __float_as_uint(v), false, false); v = __uint_as_float(rr[0]) + __uint_as_float(rr[1]); }
    return v;
}
#define LDS_WAIT() asm volatile("s_waitcnt lgkmcnt(0)" ::: "memory")

constexpr size_t MiB = 1u << 20;
constexpr size_t WS_COS = 1 * MiB, WS_SIN = 2 * MiB;
constexpr size_t WS_A_WIN = 4 * MiB, WS_A_WOUT = 36 * MiB;
constexpr size_t WS_B_WIN = 44 * MiB, WS_B_WQB = 57 * MiB, WS_B_WKVB = 60 * MiB, WS_B_WOUT = 64 * MiB;
constexpr size_t WS_H = 72 * MiB;
constexpr size_t WS_BIG = 136 * MiB;
constexpr size_t WS_QKVZ = WS_BIG;
constexpr size_t WS_WINO = WS_BIG, WS_Q = 240 * MiB, WS_KV = 336 * MiB, WS_CQN = 464 * MiB, WS_CKVN = 480 * MiB, WS_KR = 496 * MiB;
constexpr size_t WS_Y = WS_BIG;
constexpr size_t WS_B_WIN2 = 498 * MiB;
constexpr size_t WS_END = 511 * MiB;

namespace att {
using bf16x8 = __attribute__((ext_vector_type(8))) short;
using s16x4  = __attribute__((ext_vector_type(4))) short;
using f32x16 = __attribute__((ext_vector_type(16))) float;
using u32x4  = __attribute__((ext_vector_type(4))) unsigned;
constexpr int NW = 8, QBLK = 32, KVBLK = 64;
constexpr int SHM_V = 16384, SHM_KN = 16384, SHM_KR = 8192;
constexpr int L_V = 0, L_KN = 2 * SHM_V, L_KR = L_KN + 2 * SHM_KN, L_WS = L_KR + 2 * SHM_KR, L_RPB = L_WS + NW * 64 * 4, L_END = L_RPB + 4096;
#define KSWZ(row, colB) ((row) * 256 + ((colB) ^ (((row) & 15) << 4)))
#define RSWZ(row, colB) ((row) * 128 + ((colB) ^ ((((row) >> 1) & 7) << 4)))
#define SBAR() __builtin_amdgcn_sched_barrier(0)
__device__ __forceinline__ int crow(int r, int hi) { return (r & 3) + 8 * (r >> 2) + 4 * hi; }
__device__ __forceinline__ unsigned cvtpk(float lo, float hi) {
  unsigned r; asm volatile("v_cvt_pk_bf16_f32 %0, %1, %2" : "=v"(r) : "v"(lo), "v"(hi)); return r;
}
constexpr float THR = 8.f;
__device__ __forceinline__ void partialSM(f32x16& p0, f32x16& p1, float& m_reg, float& mn, float& alpha, const float C, const float THRS) {
  float pmax = p0[0];
#pragma unroll
  for (int r = 1; r < 16; ++r) pmax = fmaxf(pmax, p0[r]);
#pragma unroll
  for (int r = 0; r < 16; ++r) pmax = fmaxf(pmax, p1[r]);
  { auto rr = __builtin_amdgcn_permlane32_swap(__float_as_uint(pmax), __float_as_uint(pmax), false, false);
    pmax = fmaxf(__uint_as_float(rr[0]), __uint_as_float(rr[1])); }
  if (__builtin_expect(__all(pmax - m_reg <= THRS), 1)) { mn = m_reg; alpha = 1.f; }
  else { mn = fmaxf(m_reg, pmax); alpha = __builtin_amdgcn_exp2f((m_reg - mn) * C); m_reg = mn; }
  float mnC = -mn * C;
#pragma unroll
  for (int r = 0; r < 16; ++r) p0[r] = fmaf(p0[r], C, mnC);
#pragma unroll
  for (int r = 0; r < 16; ++r) p1[r] = fmaf(p1[r], C, mnC);
#pragma unroll
  for (int r = 0; r < 16; ++r) p0[r] = __builtin_amdgcn_exp2f(p0[r]);
}
__device__ __forceinline__ void finishSM(f32x16& p0, f32x16& p1, float alpha, float& l_reg, bf16x8& pa0, bf16x8& pa1, bf16x8& pa2, bf16x8& pa3) {
#pragma unroll
  for (int r = 0; r < 16; ++r) p1[r] = __builtin_amdgcn_exp2f(p1[r]);
  float ps = 0;
#pragma unroll
  for (int r = 0; r < 16; ++r) ps += p0[r];
#pragma unroll
  for (int r = 0; r < 16; ++r) ps += p1[r];
  { auto rr = __builtin_amdgcn_permlane32_swap(__float_as_uint(ps), __float_as_uint(ps), false, false);
    ps = __uint_as_float(rr[0]) + __uint_as_float(rr[1]); }
  l_reg = l_reg * alpha + ps;
#define PK4(P, BASE, OUT) do { unsigned a0 = cvtpk(P[BASE + 0], P[BASE + 1]), a1 = cvtpk(P[BASE + 2], P[BASE + 3]);   \
    unsigned b0 = cvtpk(P[BASE + 4], P[BASE + 5]), b1 = cvtpk(P[BASE + 6], P[BASE + 7]);                              \
    auto r0 = __builtin_amdgcn_permlane32_swap(a0, b0, false, false); auto r1 = __builtin_amdgcn_permlane32_swap(a1, b1, false, false); \
    u32x4 w = {r0[0], r1[0], r0[1], r1[1]}; OUT = *reinterpret_cast<bf16x8*>(&w); } while (0)
  PK4(p0, 0, pa0); PK4(p0, 8, pa1); PK4(p1, 0, pa2); PK4(p1, 8, pa3);
#undef PK4
}
__device__ __forceinline__ int v_st(int k, int c) { const int kk = (k & ~0xC) | ((k & 4) << 1) | ((k & 8) >> 1); return ((kk >> 3) * 4 + (c >> 5)) * 512 + ((kk & 7) * 32 + (c & 31)) * 2; }
__device__ __forceinline__ int v_rd_base(int lane) { return ((lane & 3) << 3) | (((lane >> 2) & 3) << 6) | (((lane >> 4) & 1) << 5) | (((lane >> 5) & 1) << 8); }
constexpr int v_rd_off(int d0, int ks, int half) { return d0 * 512 + ks * 4096 + half * 2048; }
template <int OFF> __device__ __forceinline__ s16x4 tr_read(int vb) {
  s16x4 r; asm volatile("ds_read_b64_tr_b16 %0, %1 offset:%2" : "=&v"(r) : "v"(vb), "i"(OFF) : "memory"); return r;
}
template <int D0> __device__ __forceinline__ void pv_one(f32x16& od, int vb, bf16x8 pa0, bf16x8 pa1, bf16x8 pa2, bf16x8 pa3) {
  const s16x4 l0 = tr_read<v_rd_off(D0, 0, 0)>(vb), h0 = tr_read<v_rd_off(D0, 0, 1)>(vb), l1 = tr_read<v_rd_off(D0, 1, 0)>(vb), h1 = tr_read<v_rd_off(D0, 1, 1)>(vb);
  const s16x4 l2 = tr_read<v_rd_off(D0, 2, 0)>(vb), h2 = tr_read<v_rd_off(D0, 2, 1)>(vb), l3 = tr_read<v_rd_off(D0, 3, 0)>(vb), h3 = tr_read<v_rd_off(D0, 3, 1)>(vb);
  asm volatile("s_waitcnt lgkmcnt(0)" ::: "memory"); SBAR();
#define PK(L, H) (bf16x8){L[0], L[1], L[2], L[3], H[0], H[1], H[2], H[3]}
  od = __builtin_amdgcn_mfma_f32_32x32x16_bf16(pa0, PK(l0, h0), od, 0, 0, 0);
  od = __builtin_amdgcn_mfma_f32_32x32x16_bf16(pa1, PK(l1, h1), od, 0, 0, 0);
  od = __builtin_amdgcn_mfma_f32_32x32x16_bf16(pa2, PK(l2, h2), od, 0, 0, 0);
  od = __builtin_amdgcn_mfma_f32_32x32x16_bf16(pa3, PK(l3, h3), od, 0, 0, 0);
#undef PK
}
__device__ __forceinline__ void pv_d0(f32x16* o, int vb, bf16x8 pa0, bf16x8 pa1, bf16x8 pa2, bf16x8 pa3) {
  pv_one<0>(o[0], vb, pa0, pa1, pa2, pa3); pv_one<1>(o[1], vb, pa0, pa1, pa2, pa3); pv_one<2>(o[2], vb, pa0, pa1, pa2, pa3); pv_one<3>(o[3], vb, pa0, pa1, pa2, pa3);
}

template <bool MLA>
__device__ __forceinline__ void attn_unit(char* lds, const bf16_t* __restrict__ Qp, const bf16_t* __restrict__ Knp, const bf16_t* __restrict__ Vp,
                                          const bf16_t* __restrict__ Krp, const bf16_t* __restrict__ Zp, bf16_t* __restrict__ Op, const int NT,
                                          const int R0, const int r0row, const float* __restrict__ rpb_h,
                                          const float* __restrict__ cs_tab, const float* __restrict__ sn_tab, const int pos0) {
  constexpr int LDQ = MLA ? QB_N : NA_N, LDK = MLA ? KVB_N : NA_N, LDZ = MLA ? MLA_NP : NA_N, NQ = MLA ? 12 : 8;
  constexpr float SCALE = MLA ? 0.07216878364870322f : 0.08838834764831845f;
  constexpr float C = SCALE * 1.4426950408889634f, THRS = THR / SCALE;
  const int tid = opaque_tid(), wid = __builtin_amdgcn_readfirstlane(tid >> 6), lane = tid & 63, r32 = lane & 31, hi = lane >> 5;
  float* wsf = (float*)(lds + L_WS) + wid * 64; float* li_l = wsf; float* al_l = wsf + 32;
  float* tab = (float*)(lds + L_RPB) + 256;
  float m_reg = -1e30f, l_reg = 0.f; f32x16 o[4] = {}; bf16x8 qr[NQ];
  const bf16_t* Qw = Qp + (long)(wid * QBLK + r32) * LDQ + hi * 8;
#pragma unroll
  for (int d0 = 0; d0 < 8; ++d0) qr[d0] = *reinterpret_cast<const bf16x8*>(Qw + d0 * 16);
  if constexpr (MLA) {
    const int pos = pos0 + wid * QBLK + r32;
#pragma unroll
    for (int d0 = 0; d0 < 4; ++d0) {
      const u32x4 raw = *reinterpret_cast<const u32x4*>(Qw + 128 + d0 * 16);
      const int i0 = d0 * 8 + hi * 4;
      const f32x4 cc = *reinterpret_cast<const f32x4*>(cs_tab + pos * 32 + i0), ss = *reinterpret_cast<const f32x4*>(sn_tab + pos * 32 + i0);
      u32x4 w;
#pragma unroll
      for (int p = 0; p < 4; ++p) { const float x1 = bf2f(raw[p] & 0xffffu), x2 = bf2f(raw[p] >> 16); w[p] = cvtpk(x1 * cc[p] - x2 * ss[p], x1 * ss[p] + x2 * cc[p]); }
      qr[8 + d0] = *reinterpret_cast<bf16x8*>(&w);
    }
  } else {
    for (int i = tid; i < 15 * 31; i += NW * 64) tab[i] = rpb_h[i] * (1.0f / SCALE);
  }
  const int sr = tid >> 4, sc = (tid & 15) * 8, vst0 = v_st(sr, sc), vst1 = v_st(32 + sr, sc);
  const int krow = tid >> 3, kcol = (tid & 7) * 8;
  const int vb0 = (int)(uintptr_t)(lds + L_V) + v_rd_base(lane);
  bf16x8 vs0, vs1, ks0, ks1, kr0;
#define SLOAD(k0) do { vs0 = *reinterpret_cast<const bf16x8*>(&Vp[(long)((k0) + sr) * LDK + sc]); vs1 = *reinterpret_cast<const bf16x8*>(&Vp[(long)((k0) + 32 + sr) * LDK + sc]); \
    ks0 = *reinterpret_cast<const bf16x8*>(&Knp[(long)((k0) + sr) * LDK + sc]); ks1 = *reinterpret_cast<const bf16x8*>(&Knp[(long)((k0) + 32 + sr) * LDK + sc]); \
    if constexpr (MLA) kr0 = *reinterpret_cast<const bf16x8*>(&Krp[(long)((k0) + krow) * 64 + kcol]); } while (0)
#define SWRITE(b) do { *(bf16x8*)(lds + L_V + (b) * SHM_V + vst0) = vs0; *(bf16x8*)(lds + L_V + (b) * SHM_V + vst1) = vs1; \
    *(bf16x8*)(lds + L_KN + (b) * SHM_KN + KSWZ(sr, sc * 2)) = ks0; *(bf16x8*)(lds + L_KN + (b) * SHM_KN + KSWZ(32 + sr, sc * 2)) = ks1; \
    if constexpr (MLA) *(bf16x8*)(lds + L_KR + (b) * SHM_KR + RSWZ(krow, kcol * 2)) = kr0; } while (0)
  const int rq = r0row + (wid >> 1), cq = 32 * (wid & 1) + r32;
  const int rs = min(max(rq - 4, 0), 120), cs = min(max(cq - 8, 0), 48);
  SLOAD(0); SWRITE(0); __syncthreads();
  for (int j = 0; j < NT; ++j) {
    const int b = j & 1;
    if (j + 1 < NT) SLOAD((j + 1) * KVBLK);
    bool active = true;
    if constexpr (!MLA) { const int R = R0 + j; active = (R >= rs) && (R < rs + 8); }
    if (active) {
      f32x16 p0 = {}, p1 = {};
      const char* Ks = lds + L_KN + b * SHM_KN;
#pragma unroll
      for (int d0 = 0; d0 < 8; ++d0) { const int cb = d0 * 32 + hi * 16;
        const bf16x8 b0 = *reinterpret_cast<const bf16x8*>(Ks + KSWZ(r32, cb));
        const bf16x8 b1 = *reinterpret_cast<const bf16x8*>(Ks + KSWZ(32 + r32, cb));
        p0 = __builtin_amdgcn_mfma_f32_32x32x16_bf16(b0, qr[d0], p0, 0, 0, 0);
        p1 = __builtin_amdgcn_mfma_f32_32x32x16_bf16(b1, qr[d0], p1, 0, 0, 0); }
      if constexpr (MLA) {
        const char* Kr = lds + L_KR + b * SHM_KR;
#pragma unroll
        for (int d0 = 0; d0 < 4; ++d0) { const int cb = d0 * 32 + hi * 16;
          const bf16x8 b0 = *reinterpret_cast<const bf16x8*>(Kr + RSWZ(r32, cb));
          const bf16x8 b1 = *reinterpret_cast<const bf16x8*>(Kr + RSWZ(32 + r32, cb));
          p0 = __builtin_amdgcn_mfma_f32_32x32x16_bf16(b0, qr[8 + d0], p0, 0, 0, 0);
          p1 = __builtin_amdgcn_mfma_f32_32x32x16_bf16(b1, qr[8 + d0], p1, 0, 0, 0); }
      } else {
        const int dr = R0 + j - rq + 7; const float* tb = tab + dr * 31 - cq + 15;
#pragma unroll
        for (int r = 0; r < 16; ++r) { const int kc = crow(r, hi);
          const float b0 = tb[kc], b1 = tb[kc + 32];
          p0[r] = ((unsigned)(kc - cs) < 16u) ? p0[r] + b0 : -INFINITY;
          p1[r] = ((unsigned)(kc + 32 - cs) < 16u) ? p1[r] + b1 : -INFINITY; }
      }
      float mn, alpha; bf16x8 pa0, pa1, pa2, pa3;
      partialSM(p0, p1, m_reg, mn, alpha, C, THRS);
      finishSM(p0, p1, alpha, l_reg, pa0, pa1, pa2, pa3);
      if (__any(alpha < 1.f)) { if (hi == 0) al_l[r32] = alpha; asm volatile("s_waitcnt lgkmcnt(0)" ::: "memory");
#pragma unroll
        for (int d = 0; d < 4; ++d)
#pragma unroll
          for (int r = 0; r < 16; ++r) o[d][r] *= al_l[crow(r, hi)]; }
      SBAR();
      pv_d0(o, vb0 + b * SHM_V, pa0, pa1, pa2, pa3);
    }
    if (j + 1 < NT) SWRITE(b ^ 1);
    __syncthreads();
  }
  if (hi == 0) li_l[r32] = l_reg; asm volatile("s_waitcnt lgkmcnt(0)" ::: "memory");
  float rli[16];
#pragma unroll
  for (int r = 0; r < 16; ++r) rli[r] = __builtin_amdgcn_rcpf(li_l[crow(r, hi)]);
  { unsigned zr[16][4];
#pragma unroll
    for (int r = 0; r < 16; ++r) { const long trow = wid * QBLK + crow(r, hi);
#pragma unroll
      for (int d0 = 0; d0 < 4; ++d0) zr[r][d0] = Zp[trow * LDZ + d0 * 32 + r32]; }
    asm volatile("s_waitcnt vmcnt(0)" ::: "memory"); SBAR();
#pragma unroll
    for (int r = 0; r < 16; ++r) { const long trow = wid * QBLK + crow(r, hi);
#pragma unroll
      for (int d0 = 0; d0 < 4; ++d0) { const float z = bf2f(zr[r][d0]); const float v = o[d0][r] * rli[r];
        const float g = v * z * __builtin_amdgcn_rcpf(1.f + __expf(-z));
        Op[((size_t)(d0 >> 1) * M_TOK + trow) * 64 + (d0 & 1) * 32 + r32] = (bf16_t)f2bf(g); } } }
  __syncthreads();
#undef SLOAD
#undef SWRITE
}
constexpr int P_V = 0, P_KN = 3 * SHM_V, P_KR = P_KN + 3 * SHM_KN, P_WS = P_KR + 3 * SHM_KR, P_END = P_WS + NW * 64 * 4;
__device__ __forceinline__ void glds16(const void* gsrc, unsigned lds_dst) { unsigned keep;
  asm volatile("s_mov_b32 %0, m0\n\ts_mov_b32 m0, %2\n\ts_nop 0\n\tglobal_load_lds_dwordx4 %1, off\n\ts_mov_b32 m0, %0" : "=&s"(keep) : "v"(gsrc), "s"(lds_dst) : "memory"); }
__device__ __forceinline__ void glds16s(const void* sbase, unsigned voff, unsigned lds_dst) { unsigned keep;
  asm volatile("s_mov_b32 %0, m0\n\ts_mov_b32 m0, %2\n\ts_nop 0\n\tglobal_load_lds_dwordx4 %1, %3\n\ts_mov_b32 m0, %0" : "=&s"(keep) : "v"(voff), "s"(lds_dst), "s"(sbase) : "memory"); }
#define WAIT_BAR(N) asm volatile("s_waitcnt vmcnt(" #N ") lgkmcnt(0)\n\ts_barrier" ::: "memory")
__device__ __forceinline__ void qkt192(f32x16& p0, f32x16& p1, const char* Ks, const char* Kr, const bf16x8* qr, int r32, int hi) {
  p0 = f32x16{}; p1 = f32x16{};
#pragma unroll
  for (int d0 = 0; d0 < 8; ++d0) { const int cb = d0 * 32 + hi * 16;
    const bf16x8 b0 = *reinterpret_cast<const bf16x8*>(Ks + KSWZ(r32, cb));
    const bf16x8 b1 = *reinterpret_cast<const bf16x8*>(Ks + KSWZ(32 + r32, cb));
    p0 = __builtin_amdgcn_mfma_f32_32x32x16_bf16(b0, qr[d0], p0, 0, 0, 0);
    p1 = __builtin_amdgcn_mfma_f32_32x32x16_bf16(b1, qr[d0], p1, 0, 0, 0); }
#pragma unroll
  for (int d0 = 0; d0 < 4; ++d0) { const int cb = d0 * 32 + hi * 16;
    const bf16x8 b0 = *reinterpret_cast<const bf16x8*>(Kr + RSWZ(r32, cb));
    const bf16x8 b1 = *reinterpret_cast<const bf16x8*>(Kr + RSWZ(32 + r32, cb));
    p0 = __builtin_amdgcn_mfma_f32_32x32x16_bf16(b0, qr[8 + d0], p0, 0, 0, 0);
    p1 = __builtin_amdgcn_mfma_f32_32x32x16_bf16(b1, qr[8 + d0], p1, 0, 0, 0); }
}


typedef short v4i16_t __attribute__((ext_vector_type(4)));
typedef __attribute__((address_space(3))) const char* lds_cptr;
__device__ __forceinline__ s16x4 vtr(lds_cptr p) { return __builtin_bit_cast(s16x4, __builtin_amdgcn_ds_read_tr16_b64_v4i16((__attribute__((address_space(3))) v4i16_t*)p)); }
#define MX3(a, b, c) __builtin_fmaxf(__builtin_fmaxf((a), (b)), (c))
__device__ __forceinline__ void qkt192n(f32x16& p0, f32x16& p1, const char* Ks, const char* Kr, const bf16x8* qr, const f32x16& negm, int r32, int hi) {
#pragma unroll
  for (int d0 = 0; d0 < 8; ++d0) { const int cb = d0 * 32 + hi * 16;
    const bf16x8 b0 = *reinterpret_cast<const bf16x8*>(Ks + KSWZ(r32, cb));
    const bf16x8 b1 = *reinterpret_cast<const bf16x8*>(Ks + KSWZ(32 + r32, cb));
    if (d0 == 0) { p0 = __builtin_amdgcn_mfma_f32_32x32x16_bf16(b0, qr[0], negm, 0, 0, 0); p1 = __builtin_amdgcn_mfma_f32_32x32x16_bf16(b1, qr[0], negm, 0, 0, 0); }
    else { p0 = __builtin_amdgcn_mfma_f32_32x32x16_bf16(b0, qr[d0], p0, 0, 0, 0); p1 = __builtin_amdgcn_mfma_f32_32x32x16_bf16(b1, qr[d0], p1, 0, 0, 0); } }
#pragma unroll
  for (int d0 = 0; d0 < 4; ++d0) { const int cb = d0 * 32 + hi * 16;
    const bf16x8 b0 = *reinterpret_cast<const bf16x8*>(Kr + RSWZ(r32, cb));
    const bf16x8 b1 = *reinterpret_cast<const bf16x8*>(Kr + RSWZ(32 + r32, cb));
    p0 = __builtin_amdgcn_mfma_f32_32x32x16_bf16(b0, qr[8 + d0], p0, 0, 0, 0);
    p1 = __builtin_amdgcn_mfma_f32_32x32x16_bf16(b1, qr[8 + d0], p1, 0, 0, 0); }
}
__device__ __forceinline__ float rowmax32(const f32x16& p0, const f32x16& p1) {
  float a = MX3(p0[0], p0[1], p1[0]), b = MX3(p0[2], p0[3], p1[1]); a = MX3(a, p1[2], p1[3]);
#pragma unroll
  for (int r = 4; r < 16; r += 4) { a = MX3(a, p0[r], p0[r + 1]); b = MX3(b, p0[r + 2], p0[r + 3]); a = MX3(a, p1[r], p1[r + 1]); b = MX3(b, p1[r + 2], p1[r + 3]); }
  float m = __builtin_fmaxf(a, b);
  auto rr = __builtin_amdgcn_permlane32_swap(__float_as_uint(m), __float_as_uint(m), false, false);
  return __builtin_fmaxf(__uint_as_float(rr[0]), __uint_as_float(rr[1]));
}
__device__ __forceinline__ void finishSMn(f32x16& p0, f32x16& p1, float& l_reg, bf16x8& pa0, bf16x8& pa1, bf16x8& pa2, bf16x8& pa3) {
#pragma unroll
  for (int r = 0; r < 16; ++r) p1[r] = __builtin_amdgcn_exp2f(p1[r]);
  float ps = 0, ps2 = 0;
#pragma unroll
  for (int r = 0; r < 16; ++r) ps += p0[r];
#pragma unroll
  for (int r = 0; r < 16; ++r) ps2 += p1[r];
  ps += ps2;
  { auto rr = __builtin_amdgcn_permlane32_swap(__float_as_uint(ps), __float_as_uint(ps), false, false);
    ps = __uint_as_float(rr[0]) + __uint_as_float(rr[1]); }
  l_reg += ps;
#define PK4(P, BASE, OUT) do { unsigned a0 = cvtpk(P[BASE + 0], P[BASE + 1]), a1 = cvtpk(P[BASE + 2], P[BASE + 3]);   \
    unsigned b0 = cvtpk(P[BASE + 4], P[BASE + 5]), b1 = cvtpk(P[BASE + 6], P[BASE + 7]);                              \
    auto r0 = __builtin_amdgcn_permlane32_swap(a0, b0, false, false); auto r1 = __builtin_amdgcn_permlane32_swap(a1, b1, false, false); \
    u32x4 w = {r0[0], r1[0], r0[1], r1[1]}; OUT = *reinterpret_cast<bf16x8*>(&w); } while (0)
  PK4(p0, 0, pa0); PK4(p0, 8, pa1); PK4(p1, 0, pa2); PK4(p1, 8, pa3);
#undef PK4
}
__device__ __forceinline__ void mla_unit(char* lds, const bf16_t* __restrict__ Qp, const bf16_t* __restrict__ Knp, const bf16_t* __restrict__ Vp,
                                         const bf16_t* __restrict__ Krp, const bf16_t* __restrict__ Zp, bf16_t* __restrict__ Op, const int NT,
                                         const float* __restrict__ cs_tab, const float* __restrict__ sn_tab, const int pos0,
                                         const bf16_t* nKnp, const bf16_t* nVp, const bf16_t* nKrp, const bool first, const bool has_next) {
  constexpr int LDQ = QB_N, LDK = 256, LDZ = 256;
  constexpr float SCALE = 0.07216878364870322f;
  constexpr float C = SCALE * 1.4426950408889634f, THRS = THR / SCALE;
  const int tid = opaque_tid(), wid = __builtin_amdgcn_readfirstlane(tid >> 6), lane = tid & 63, r32 = lane & 31, hi = lane >> 5;
  float* wsf = (float*)(lds + P_WS) + wid * 64; float* li_l = wsf; float* al_l = wsf + 32;
  const unsigned lds0 = (unsigned)(uintptr_t)lds;
  const int pk = (wid & 3) + 8 * (wid >> 2);
  const int krow_n = 4 * pk + (lane >> 4);
  const unsigned kn_off = (unsigned)(krow_n * LDK + (((lane & 15) ^ (krow_n & 15)) << 3)) * 2u;
  const int krow_r = 8 * wid + (lane >> 3);
  const unsigned kr_off = (unsigned)(krow_r * 64 + (((lane & 7) ^ ((krow_r >> 1) & 7)) << 3)) * 2u;
  const int vst_ = 2 * wid + (lane >> 5), vkk = (vst_ >> 2) * 8 + ((lane >> 2) & 7), vkey = (vkk & ~0xC) | ((vkk & 4) << 1) | ((vkk & 8) >> 1), vcol = (vst_ & 3) * 32 + (lane & 3) * 8;
  const unsigned v_off = (unsigned)(vkey * LDK + vcol) * 2u;
  const unsigned kn_dst = lds0 + P_KN + pk * 1024, kr_dst = lds0 + P_KR + wid * 1024, v_dst = lds0 + P_V + wid * 1024;
#define DMA_K(t, slot) do { const bf16_t* s_ = Knp + (long)(t) * (KVBLK * LDK); const unsigned d_ = (unsigned)__builtin_amdgcn_readfirstlane(kn_dst + (slot) * SHM_KN); \
    glds16s(s_, kn_off, d_); glds16s(s_ + 16 * LDK, kn_off, d_ + 4096); glds16s(Krp + (long)(t) * (KVBLK * 64), kr_off, (unsigned)__builtin_amdgcn_readfirstlane(kr_dst + (slot) * SHM_KR)); } while (0)
#define DMA_V(t, slot) do { const bf16_t* s_ = Vp + (long)(t) * (KVBLK * LDK); const unsigned d_ = (unsigned)__builtin_amdgcn_readfirstlane(v_dst + (slot) * SHM_V); \
    glds16s(s_, v_off, d_); glds16s(s_ + 32 * LDK, v_off, d_ + 8192); } while (0)
#define DMA_K2(KB, RB, t, slot) do { const bf16_t* s_ = (KB) + (long)(t) * (KVBLK * LDK); const unsigned d_ = (unsigned)__builtin_amdgcn_readfirstlane(kn_dst + (slot) * SHM_KN); \
    glds16s(s_, kn_off, d_); glds16s(s_ + 16 * LDK, kn_off, d_ + 4096); glds16s((RB) + (long)(t) * (KVBLK * 64), kr_off, (unsigned)__builtin_amdgcn_readfirstlane(kr_dst + (slot) * SHM_KR)); } while (0)
#define DMA_V2(VB, t, slot) do { const bf16_t* s_ = (VB) + (long)(t) * (KVBLK * LDK); const unsigned d_ = (unsigned)__builtin_amdgcn_readfirstlane(v_dst + (slot) * SHM_V); \
    glds16s(s_, v_off, d_); glds16s(s_ + 32 * LDK, v_off, d_ + 8192); } while (0)
  if (first) { DMA_K(0, 0); DMA_V(0, 0); DMA_K(1, 1); DMA_V(1, 1); DMA_K(2, 2); }
  float l_reg = 0.f; f32x16 o[4] = {}; bf16x8 qr[12];
  const bf16_t* Qw = Qp + (long)(wid * QBLK + r32) * LDQ + hi * 8;
#pragma unroll
  for (int d0 = 0; d0 < 8; ++d0) { const u32x4 raw = *reinterpret_cast<const u32x4*>(Qw + d0 * 16); u32x4 w;
#pragma unroll
    for (int p = 0; p < 4; ++p) w[p] = cvtpk(bf2f(raw[p] & 0xffffu) * C, bf2f(raw[p] >> 16) * C);
    qr[d0] = *reinterpret_cast<bf16x8*>(&w); }
  { const int pos = pos0 + wid * QBLK + r32;
#pragma unroll
    for (int d0 = 0; d0 < 4; ++d0) {
      const u32x4 raw = *reinterpret_cast<const u32x4*>(Qw + 128 + d0 * 16);
      const int i0 = d0 * 8 + hi * 4;
      const f32x4 cc = *reinterpret_cast<const f32x4*>(cs_tab + pos * 32 + i0) * C, ss = *reinterpret_cast<const f32x4*>(sn_tab + pos * 32 + i0) * C;
      u32x4 w;
#pragma unroll
      for (int p = 0; p < 4; ++p) { const float x1 = bf2f(raw[p] & 0xffffu), x2 = bf2f(raw[p] >> 16); w[p] = cvtpk(x1 * cc[p] - x2 * ss[p], x1 * ss[p] + x2 * cc[p]); }
      qr[8 + d0] = *reinterpret_cast<bf16x8*>(&w);
    } }
  f32x16 pA0, pA1, pB0, pB1; bf16x8 pa0, pa1, pa2, pa3;
  constexpr float THRL = THR * 1.4426950408889634f;
  float mhat = 0.f; f32x16 negm = f32x16{}; asm volatile("" : "+v"(negm));
  const lds_cptr vp0 = (lds_cptr)lds + P_V + v_rd_base(lane);
  const lds_cptr kn0 = (lds_cptr)lds + P_KN, kr0 = (lds_cptr)lds + P_KR;
#define NEWMAX(P0, P1, FORCE) do { const float rm = rowmax32(P0, P1); resc = false; \
    if ((FORCE) || __builtin_expect(__any(rm > THRL), 0)) { const float dl = (FORCE) ? rm : __builtin_fmaxf(rm, 0.f); mhat += dl; \
      _Pragma("unroll") for (int r = 0; r < 16; ++r) { P0[r] -= dl; P1[r] -= dl; } \
      _Pragma("unroll") for (int r = 0; r < 16; ++r) negm[r] = -mhat; asm volatile("" : "+v"(negm)); \
      const float f = __builtin_amdgcn_exp2f(-dl); l_reg *= f; if (hi == 0) al_l[r32] = f; resc = true; } } while (0)
#define NEWMAX_TAIL(P0, P1, RM) do { resc = false; \
    if (__builtin_expect(__any((RM) > THRL), 0)) { const float dl = __builtin_fmaxf((RM), 0.f); mhat += dl; \
      _Pragma("unroll") for (int r = 0; r < 16; ++r) { P0[r] -= dl; P1[r] -= dl; } \
      _Pragma("unroll") for (int r = 0; r < 16; ++r) negm[r] = -mhat; asm volatile("" : "+v"(negm)); \
      const float f = __builtin_amdgcn_exp2f(-dl); l_reg *= f; if (hi == 0) al_l[r32] = f; resc = true; } } while (0)
#define RESC() do { if (resc) { asm volatile("s_waitcnt lgkmcnt(0)" ::: "memory"); \
    _Pragma("unroll") for (int d = 0; d < 4; ++d) _Pragma("unroll") for (int r = 0; r < 16; ++r) o[d][r] *= al_l[crow(r, hi)]; } } while (0)
#define EXP16(P) do { _Pragma("unroll") for (int r = 0; r < 16; ++r) P[r] = __builtin_amdgcn_exp2f(P[r]); } while (0)
#define PIN(x) asm volatile("" : "+v"(x))
#define LDSV(T, p) (*(const __attribute__((address_space(3))) T*)(p))
#define KLD1(G, F) do { const int D_ = (G) >> 1, W_ = (G) & 1; \
    if (D_ < 8) { F = LDSV(bf16x8, kn0 + kso + KSWZ(32 * W_ + r32, D_ * 32 + hi * 16)); } \
    else { F = LDSV(bf16x8, kr0 + kro + RSWZ(32 * W_ + r32, (D_ - 8) * 32 + hi * 16)); } } while (0)
#define VLD(H, F) do { F[0] = vtr(vp0 + vso + v_rd_off((H) & 3, (H) >> 2, 0)); F[1] = vtr(vp0 + vso + v_rd_off((H) & 3, (H) >> 2, 1)); } while (0)
#define PSWAP(A0, A1, B0, B1, OUT) do { auto r0_ = __builtin_amdgcn_permlane32_swap(A0, B0, false, false); auto r1_ = __builtin_amdgcn_permlane32_swap(A1, B1, false, false); \
    u32x4 w_ = {r0_[0], r1_[0], r0_[1], r1_[1]}; OUT = __builtin_bit_cast(bf16x8, w_); } while (0)
  bool resc = false; float sum0 = 0.f;
#define HALF0(P0) do { sum0 = 0.f; _Pragma("unroll") for (int r = 0; r < 16; ++r) sum0 += P0[r]; \
    { unsigned a0_ = cvtpk(P0[0], P0[1]), a1_ = cvtpk(P0[2], P0[3]), b0_ = cvtpk(P0[4], P0[5]), b1_ = cvtpk(P0[6], P0[7]); PSWAP(a0_, a1_, b0_, b1_, pa0); } \
    { unsigned a0_ = cvtpk(P0[8], P0[9]), a1_ = cvtpk(P0[10], P0[11]), b0_ = cvtpk(P0[12], P0[13]), b1_ = cvtpk(P0[14], P0[15]); PSWAP(a0_, a1_, b0_, b1_, pa1); } } while (0)
#define DMA_PIECE(i, j) do { \
    if ((i) < 2) { if ((j) + 2 < NT) { const bf16_t* s_ = Vp + (long)((j) + 2) * (KVBLK * LDK) + (i) * 32 * LDK; glds16s(s_, v_off, (unsigned)__builtin_amdgcn_readfirstlane(v_dst + s2 * SHM_V + (i) * 8192)); } } \
    else if ((i) < 4) { if ((j) + 3 < NT) { const bf16_t* s_ = Knp + (long)((j) + 3) * (KVBLK * LDK) + ((i) - 2) * 16 * LDK; glds16s(s_, kn_off, (unsigned)__builtin_amdgcn_readfirstlane(kn_dst + s0 * SHM_KN + ((i) - 2) * 4096)); } } \
    else { if ((j) + 3 < NT) glds16s(Krp + (long)((j) + 3) * (KVBLK * 64), kr_off, (unsigned)__builtin_amdgcn_readfirstlane(kr_dst + s0 * SHM_KR)); } } while (0)
  WAIT_BAR(10);
  qkt192n(pA0, pA1, (const char*)lds + P_KN, (const char*)lds + P_KR, qr, negm, r32, hi); NEWMAX(pA0, pA1, true); EXP16(pA0); HALF0(pA0);
  int s0 = 0, s1 = 1, s2 = 2;
#define STEP(PC0, PC1, PN0, PN1, j) do { \
    if ((j) + 2 < NT) WAIT_BAR(5); else WAIT_BAR(2); \
    const int kso = s1 * SHM_KN, kro = s1 * SHM_KR, vso = s0 * SHM_V; \
    bf16x8 kf[5]; s16x4 vf[4][2]; unsigned ca0, ca1, cb0, cb1; float sumA = sum0; \
    SBAR(); KLD1(0, kf[0]); KLD1(1, kf[1]); KLD1(2, kf[2]); KLD1(3, kf[3]); SBAR(); \
    _Pragma("unroll") for (int g = 0; g < 24; ++g) { const int d = g >> 1, w = g & 1; \
      if (g + 4 < 24) KLD1(g + 4, kf[(g + 4) % 5]); \
      if (g == 21) { VLD(0, vf[0]); } if (g == 22) { VLD(1, vf[1]); } if (g == 23) { VLD(2, vf[2]); } \
      if (w == 0) PN0 = __builtin_amdgcn_mfma_f32_32x32x16_bf16(kf[g % 5], qr[d], (d == 0) ? negm : PN0, 0, 0, 0); \
      else        PN1 = __builtin_amdgcn_mfma_f32_32x32x16_bf16(kf[g % 5], qr[d], (d == 0) ? negm : PN1, 0, 0, 0); \
      if (g < 16) { PC1[g] = __builtin_amdgcn_exp2f(PC1[g]); if (g >= 1) sumA += PC1[g - 1]; PIN(sumA); } \
      if (g == 16) { sumA += PC1[15]; PIN(sumA); } \
      if (g == 9) { ca0 = cvtpk(PC1[0], PC1[1]); ca1 = cvtpk(PC1[2], PC1[3]); } \
      if (g == 10) { cb0 = cvtpk(PC1[4], PC1[5]); cb1 = cvtpk(PC1[6], PC1[7]); } \
      if (g == 11) { PSWAP(ca0, ca1, cb0, cb1, pa2); PIN(pa2); } \
      if (g == 17) { ca0 = cvtpk(PC1[8], PC1[9]); ca1 = cvtpk(PC1[10], PC1[11]); } \
      if (g == 18) { cb0 = cvtpk(PC1[12], PC1[13]); cb1 = cvtpk(PC1[14], PC1[15]); } \
      if (g == 19) { PSWAP(ca0, ca1, cb0, cb1, pa3); PIN(pa3); } \
      if (g == 20) { auto rr_ = __builtin_amdgcn_permlane32_swap(__float_as_uint(sumA), __float_as_uint(sumA), false, false); \
                     l_reg += __uint_as_float(rr_[0]) + __uint_as_float(rr_[1]); PIN(l_reg); } \
      SBAR(); } \
    sum0 = 0.f; SBAR(); \
    _Pragma("unroll") for (int h = 0; h < 16; ++h) { \
      if (h + 3 < 16) VLD(h + 3, vf[(h + 3) & 3]); \
      if (h < 5) DMA_PIECE(h, j); \
      { const bf16x8 vb_ = (bf16x8){vf[h & 3][0][0], vf[h & 3][0][1], vf[h & 3][0][2], vf[h & 3][0][3], vf[h & 3][1][0], vf[h & 3][1][1], vf[h & 3][1][2], vf[h & 3][1][3]}; \
        const bf16x8 pa_ = (h >> 2) == 0 ? pa0 : (h >> 2) == 1 ? pa1 : (h >> 2) == 2 ? pa2 : pa3; \
        o[h & 3] = __builtin_amdgcn_mfma_f32_32x32x16_bf16(pa_, vb_, o[h & 3], 0, 0, 0); } \
      if (h >= 4 && h < 12) { PN0[2 * h - 8] = __builtin_amdgcn_exp2f(PN0[2 * h - 8]); PN0[2 * h - 7] = __builtin_amdgcn_exp2f(PN0[2 * h - 7]); if (h >= 5) { sum0 += PN0[2 * h - 10]; sum0 += PN0[2 * h - 9]; } PIN(PN0); PIN(sum0); } \
      if (h == 12) { sum0 += PN0[14]; sum0 += PN0[15]; PIN(sum0); } \
      if (h == 8) { ca0 = cvtpk(PN0[0], PN0[1]); ca1 = cvtpk(PN0[2], PN0[3]); } \
      if (h == 9) { cb0 = cvtpk(PN0[4], PN0[5]); cb1 = cvtpk(PN0[6], PN0[7]); } \
      if (h == 10) { PSWAP(ca0, ca1, cb0, cb1, pa0); PIN(pa0); } \
      if (h == 12) { ca0 = cvtpk(PN0[8], PN0[9]); ca1 = cvtpk(PN0[10], PN0[11]); } \
      if (h == 13) { cb0 = cvtpk(PN0[12], PN0[13]); cb1 = cvtpk(PN0[14], PN0[15]); } \
      if (h == 14) { PSWAP(ca0, ca1, cb0, cb1, pa1); PIN(pa1); } \
      SBAR(); \
      if (h == 3) { NEWMAX(PN0, PN1, false); SBAR(); } } \
    RESC(); { const int t_ = s0; s0 = s1; s1 = s2; s2 = t_; } } while (0)
  int j = 0;
  for (; j + 2 < NT; j += 2) { STEP(pA0, pA1, pB0, pB1, j); STEP(pB0, pB1, pA0, pA1, j + 1); }
  STEP(pA0, pA1, pB0, pB1, j);
  WAIT_BAR(0);
  { EXP16(pB1); float s_ = sum0;
#pragma unroll
    for (int r = 0; r < 16; ++r) s_ += pB1[r];
    auto rr_ = __builtin_amdgcn_permlane32_swap(__float_as_uint(s_), __float_as_uint(s_), false, false); l_reg += __uint_as_float(rr_[0]) + __uint_as_float(rr_[1]);
    { unsigned a0_ = cvtpk(pB1[0], pB1[1]), a1_ = cvtpk(pB1[2], pB1[3]), b0_ = cvtpk(pB1[4], pB1[5]), b1_ = cvtpk(pB1[6], pB1[7]); PSWAP(a0_, a1_, b0_, b1_, pa2); }
    { unsigned a0_ = cvtpk(pB1[8], pB1[9]), a1_ = cvtpk(pB1[10], pB1[11]), b0_ = cvtpk(pB1[12], pB1[13]), b1_ = cvtpk(pB1[14], pB1[15]); PSWAP(a0_, a1_, b0_, b1_, pa3); } }
  SBAR();
  pv_d0(o, (int)(lds0 + P_V) + v_rd_base(lane) + s0 * SHM_V, pa0, pa1, pa2, pa3);
  asm volatile("s_waitcnt lgkmcnt(0)\n\ts_barrier" ::: "memory");
  if (has_next) { DMA_K2(nKnp, nKrp, 0, 0); DMA_V2(nVp, 0, 0); DMA_K2(nKnp, nKrp, 1, 1); DMA_V2(nVp, 1, 1); DMA_K2(nKnp, nKrp, 2, 2); }
  if (hi == 0) li_l[r32] = l_reg; asm volatile("s_waitcnt lgkmcnt(0)" ::: "memory");
  float rli[16];
#pragma unroll
  for (int r = 0; r < 16; ++r) rli[r] = __builtin_amdgcn_rcpf(li_l[crow(r, hi)]);
  { unsigned zr[16][4];
#pragma unroll
    for (int r = 0; r < 16; ++r) { const long trow = wid * QBLK + crow(r, hi);
#pragma unroll
      for (int d0 = 0; d0 < 4; ++d0) zr[r][d0] = Zp[trow * LDZ + d0 * 32 + r32]; }
    asm volatile("s_waitcnt vmcnt(0)" ::: "memory"); SBAR();
#pragma unroll
    for (int r = 0; r < 16; ++r) { const long trow = wid * QBLK + crow(r, hi);
#pragma unroll
      for (int d0 = 0; d0 < 4; ++d0) { const float z = bf2f(zr[r][d0]); const float v = o[d0][r] * rli[r];
        const float g = v * z * __builtin_amdgcn_rcpf(1.f + __expf(-z));
        Op[((size_t)(d0 >> 1) * M_TOK + trow) * 64 + (d0 & 1) * 32 + r32] = (bf16_t)f2bf(g); } } }
  asm volatile("s_waitcnt vmcnt(0) lgkmcnt(0)\n\ts_barrier" ::: "memory");
#undef DMA_K
#undef DMA_V
#undef DMA_K2
#undef DMA_V2
#undef RESC
#undef STEP
#undef NEWMAX
#undef NEWMAX_TAIL
#undef EXP16
#undef PIN
#undef LDSV
#undef KLD1
#undef VLD
#undef PSWAP
#undef HALF0
#undef DMA_PIECE
}
#undef WAIT_BAR
#undef MX3
__device__ __forceinline__ void na_unit(char* lds, const bf16_t* __restrict__ Qp, const bf16_t* __restrict__ Knp, const bf16_t* __restrict__ Vp,
                                        const bf16_t* __restrict__ Zp, bf16_t* __restrict__ Op, const int NT, const int R0, const int r0row, const float* __restrict__ rpb_h) {
  constexpr int LDQ = NA_N, LDK = NA_N, LDZ = NA_N;
  constexpr float SCALE = 0.08838834764831845f;
  constexpr float C = SCALE * 1.4426950408889634f, THRS = THR / SCALE;
  constexpr int N_TAB = P_WS + NW * 64 * 4;
  const int tid = opaque_tid(), wid = __builtin_amdgcn_readfirstlane(tid >> 6), lane = tid & 63, r32 = lane & 31, hi = lane >> 5;
  float* wsf = (float*)(lds + P_WS) + wid * 64; float* li_l = wsf; float* al_l = wsf + 32;
  float* tab = (float*)(lds + N_TAB) + 256;
  const unsigned lds0 = (unsigned)(uintptr_t)lds;
  const int pk = (wid & 3) + 8 * (wid >> 2);
  const int krow_n = 4 * pk + (lane >> 4);
  const unsigned kn_off = (unsigned)(krow_n * LDK + (((lane & 15) ^ (krow_n & 15)) << 3)) * 2u;
  const int vst_ = 2 * wid + (lane >> 5), vkk = (vst_ >> 2) * 8 + ((lane >> 2) & 7), vkey = (vkk & ~0xC) | ((vkk & 4) << 1) | ((vkk & 8) >> 1), vcol = (vst_ & 3) * 32 + (lane & 3) * 8;
  const unsigned v_off = (unsigned)(vkey * LDK + vcol) * 2u;
  const unsigned kn_dst = lds0 + P_KN + pk * 1024, v_dst = lds0 + P_V + wid * 1024;
#define DMA_T(t, slot) do { const bf16_t* sk_ = Knp + (long)(t) * (KVBLK * LDK); const bf16_t* sv_ = Vp + (long)(t) * (KVBLK * LDK); \
    const unsigned dk_ = (unsigned)__builtin_amdgcn_readfirstlane(kn_dst + (slot) * SHM_KN), dv_ = (unsigned)__builtin_amdgcn_readfirstlane(v_dst + (slot) * SHM_V); \
    glds16s(sk_, kn_off, dk_); glds16s(sk_ + 16 * LDK, kn_off, dk_ + 4096); glds16s(sv_, v_off, dv_); glds16s(sv_ + 32 * LDK, v_off, dv_ + 8192); } while (0)
  DMA_T(0, 0); DMA_T(1, 1);
  float m_reg = -1e30f, l_reg = 0.f; f32x16 o[4] = {}; bf16x8 qr[8];
  const bf16_t* Qw = Qp + (long)(wid * QBLK + r32) * LDQ + hi * 8;
#pragma unroll
  for (int d0 = 0; d0 < 8; ++d0) qr[d0] = *reinterpret_cast<const bf16x8*>(Qw + d0 * 16);
  for (int i = tid; i < 15 * 31; i += NW * 64) tab[i] = rpb_h[i] * (1.0f / SCALE);
  const int vb0 = (int)(lds0 + P_V) + v_rd_base(lane);
  const int rq = r0row + (wid >> 1), cq = 32 * (wid & 1) + r32;
  const int rs = min(max(rq - 4, 0), 120), cs = min(max(cq - 8, 0), 48);
  int s0 = 0, s2 = 2;
  for (int j = 0; j < NT; ++j) {
    if (j + 1 < NT) asm volatile("s_waitcnt vmcnt(4) lgkmcnt(0)\n\ts_barrier" ::: "memory"); else asm volatile("s_waitcnt vmcnt(0) lgkmcnt(0)\n\ts_barrier" ::: "memory");
    if (j + 2 < NT) DMA_T(j + 2, s2);
    const int R = R0 + j;
    if ((R >= rs) && (R < rs + 8)) {
      f32x16 p0 = {}, p1 = {};
      const char* Ks = lds + P_KN + s0 * SHM_KN;
#pragma unroll
      for (int d0 = 0; d0 < 8; ++d0) { const int cb = d0 * 32 + hi * 16;
        const bf16x8 b0 = *reinterpret_cast<const bf16x8*>(Ks + KSWZ(r32, cb));
        const bf16x8 b1 = *reinterpret_cast<const bf16x8*>(Ks + KSWZ(32 + r32, cb));
        p0 = __builtin_amdgcn_mfma_f32_32x32x16_bf16(b0, qr[d0], p0, 0, 0, 0);
        p1 = __builtin_amdgcn_mfma_f32_32x32x16_bf16(b1, qr[d0], p1, 0, 0, 0); }
      { const int dr = R - rq + 7; const float* tb = tab + dr * 31 - cq + 15;
#pragma unroll
        for (int r = 0; r < 16; ++r) { const int kc = crow(r, hi);
          const float b0 = tb[kc], b1 = tb[kc + 32];
          p0[r] = ((unsigned)(kc - cs) < 16u) ? p0[r] + b0 : -INFINITY;
          p1[r] = ((unsigned)(kc + 32 - cs) < 16u) ? p1[r] + b1 : -INFINITY; } }
      float mn, alpha; bf16x8 pa0, pa1, pa2, pa3;
      partialSM(p0, p1, m_reg, mn, alpha, C, THRS);
      finishSM(p0, p1, alpha, l_reg, pa0, pa1, pa2, pa3);
      if (__any(alpha < 1.f)) { if (hi == 0) al_l[r32] = alpha; asm volatile("s_waitcnt lgkmcnt(0)" ::: "memory");
#pragma unroll
        for (int d = 0; d < 4; ++d)
#pragma unroll
          for (int r = 0; r < 16; ++r) o[d][r] *= al_l[crow(r, hi)]; }
      SBAR();
      pv_d0(o, vb0 + s0 * SHM_V, pa0, pa1, pa2, pa3);
    }
    s0 = (s0 == 2) ? 0 : s0 + 1; s2 = (s2 == 2) ? 0 : s2 + 1;
  }
  if (hi == 0) li_l[r32] = l_reg; asm volatile("s_waitcnt lgkmcnt(0)" ::: "memory");
  float rli[16];
#pragma unroll
  for (int r = 0; r < 16; ++r) rli[r] = __builtin_amdgcn_rcpf(li_l[crow(r, hi)]);
  { unsigned zr[16][4];
#pragma unroll
    for (int r = 0; r < 16; ++r) { const long trow = wid * QBLK + crow(r, hi);
#pragma unroll
      for (int d0 = 0; d0 < 4; ++d0) zr[r][d0] = Zp[trow * LDZ + d0 * 32 + r32]; }
    asm volatile("s_waitcnt vmcnt(0)" ::: "memory"); SBAR();
#pragma unroll
    for (int r = 0; r < 16; ++r) { const long trow = wid * QBLK + crow(r, hi);
#pragma unroll
      for (int d0 = 0; d0 < 4; ++d0) { const float z = bf2f(zr[r][d0]); const float v = o[d0][r] * rli[r];
        const float g = v * z * __builtin_amdgcn_rcpf(1.f + __expf(-z));
        Op[((size_t)(d0 >> 1) * M_TOK + trow) * 64 + (d0 & 1) * 32 + r32] = (bf16_t)f2bf(g); } } }
  asm volatile("s_waitcnt vmcnt(0) lgkmcnt(0)\n\ts_barrier" ::: "memory");
#undef DMA_T
}
__device__ __forceinline__ void na_unit3(char* lds, const bf16_t* __restrict__ Qp, const bf16_t* __restrict__ Knp, const bf16_t* __restrict__ Vp,
                                         const bf16_t* __restrict__ Zp, bf16_t* __restrict__ Op, const int NT, const int R0, const int r0row, const float* __restrict__ rpb_h) {
  constexpr int LDQ = 256, LDK = 256, LDZ = 256;
  constexpr float SCALE = 0.08838834764831845f;
  constexpr float C = SCALE * 1.4426950408889634f;
  constexpr float THRL = THR * 1.4426950408889634f;
  constexpr int N_V = 0, N_KN = 4 * SHM_V, N_WS = N_KN + 4 * SHM_KN, N_TAB = N_WS + NW * 64 * 4;
  const int tid = opaque_tid(), wid = __builtin_amdgcn_readfirstlane(tid >> 6), lane = tid & 63, r32 = lane & 31, hi = lane >> 5;
  float* wsf = (float*)(lds + N_WS) + wid * 64; float* li_l = wsf; float* al_l = wsf + 32;
  float* tab = (float*)(lds + N_TAB) + 256;
  const unsigned lds0 = (unsigned)(uintptr_t)lds;
  const int pk = (wid & 3) + 8 * (wid >> 2);
  const int krow_n = 4 * pk + (lane >> 4);
  const unsigned kn_off = (unsigned)(krow_n * LDK + (((lane & 15) ^ (krow_n & 15)) << 3)) * 2u;
  const int vst_ = 2 * wid + (lane >> 5), vkk = (vst_ >> 2) * 8 + ((lane >> 2) & 7), vkey = (vkk & ~0xC) | ((vkk & 4) << 1) | ((vkk & 8) >> 1), vcol = (vst_ & 3) * 32 + (lane & 3) * 8;
  const unsigned v_off = (unsigned)(vkey * LDK + vcol) * 2u;
  const unsigned kn_dst = lds0 + N_KN + pk * 1024, v_dst = lds0 + N_V + wid * 1024;
#define DMA_T(t, slot) do { const bf16_t* sk_ = Knp + (long)(t) * (KVBLK * LDK); const bf16_t* sv_ = Vp + (long)(t) * (KVBLK * LDK); \
    const unsigned dk_ = (unsigned)__builtin_amdgcn_readfirstlane(kn_dst + (slot) * SHM_KN), dv_ = (unsigned)__builtin_amdgcn_readfirstlane(v_dst + (slot) * SHM_V); \
    glds16s(sk_, kn_off, dk_); glds16s(sk_ + 16 * LDK, kn_off, dk_ + 4096); glds16s(sv_, v_off, dv_); glds16s(sv_ + 32 * LDK, v_off, dv_ + 8192); } while (0)
  DMA_T(0, 0); DMA_T(1, 1); DMA_T(2, 2);
  float l_reg = 0.f; f32x16 o[4] = {}; bf16x8 qr[8];
  const bf16_t* Qw = Qp + (long)(wid * QBLK + r32) * LDQ + hi * 8;
#pragma unroll
  for (int d0 = 0; d0 < 8; ++d0) { const u32x4 raw = *reinterpret_cast<const u32x4*>(Qw + d0 * 16); u32x4 w;
#pragma unroll
    for (int p = 0; p < 4; ++p) w[p] = cvtpk(bf2f(raw[p] & 0xffffu) * C, bf2f(raw[p] >> 16) * C);
    qr[d0] = *reinterpret_cast<bf16x8*>(&w); }
  for (int i = tid; i < 15 * 31; i += NW * 64) tab[i] = rpb_h[i] * 1.4426950408889634f;
  const int rot = 16 * (wid & 1);
  const lds_cptr vp0 = (lds_cptr)lds + N_V + v_rd_base(lane) + rot * 256; const lds_cptr kn0 = (lds_cptr)lds + N_KN;
  const int rq = r0row + (wid >> 1), cq = 32 * (wid & 1) + r32;
  const int rs = min(max(rq - 4, 0), 120), cs = min(max(cq - 8, 0), 48);
  const int t_lo = rs - R0;
  f32x16 pA0, pA1, pB0, pB1; bf16x8 pa0, pa1, pa2, pa3;
  float mhat = 0.f; f32x16 negm = f32x16{}; asm volatile("" : "+v"(negm));
  bool resc = false; float sum0 = 0.f;
#define MX3(a, b, c) __builtin_fmaxf(__builtin_fmaxf((a), (b)), (c))
#define WAIT_BAR0() asm volatile("s_waitcnt vmcnt(0) lgkmcnt(0)\n\ts_barrier" ::: "memory")
#define WAIT_BAR4() asm volatile("s_waitcnt vmcnt(4) lgkmcnt(0)\n\ts_barrier" ::: "memory")
#define NEWMAX(P0, P1, FORCE) do { float rm; { float a_ = MX3(P0[0], P0[1], P1[0]), b_ = MX3(P0[2], P0[3], P1[1]); a_ = MX3(a_, P1[2], P1[3]); \
      _Pragma("unroll") for (int r = 4; r < 16; r += 4) { a_ = MX3(a_, P0[r], P0[r + 1]); b_ = MX3(b_, P0[r + 2], P0[r + 3]); } a_ = MX3(a_, P1[4], P1[5]); b_ = MX3(b_, P1[6], P1[7]); rm = __builtin_fmaxf(a_, b_); \
      auto rr_ = __builtin_amdgcn_permlane32_swap(__float_as_uint(rm), __float_as_uint(rm), false, false); rm = __builtin_fmaxf(__uint_as_float(rr_[0]), __uint_as_float(rr_[1])); } resc = false; \
    if ((FORCE) || __builtin_expect(__any(rm > THRL), 0)) { const float dl = (FORCE) ? rm : __builtin_fmaxf(rm, 0.f); mhat += dl; \
      _Pragma("unroll") for (int r = 0; r < 16; ++r) { P0[r] -= dl; if (r < 8) P1[r] -= dl; } \
      _Pragma("unroll") for (int r = 0; r < 16; ++r) negm[r] = -mhat; asm volatile("" : "+v"(negm)); \
      const float f = __builtin_amdgcn_exp2f(-dl); l_reg *= f; if (hi == 0) al_l[r32] = f; resc = true; } } while (0)
#define RESC() do { if (resc) { asm volatile("s_waitcnt lgkmcnt(0)" ::: "memory"); \
    _Pragma("unroll") for (int d = 0; d < 4; ++d) _Pragma("unroll") for (int r = 0; r < 16; ++r) o[d][r] *= al_l[crow(r, hi)]; } } while (0)
#define EXP16(P) do { _Pragma("unroll") for (int r = 0; r < 16; ++r) P[r] = __builtin_amdgcn_exp2f(P[r]); } while (0)
#define PIN(x) asm volatile("" : "+v"(x))
#define KLDN(G, F) do { F = *(const __attribute__((address_space(3))) bf16x8*)(kn0 + kso + KSWZ(32 * ((G) & 1) + r32 + rot, ((G) >> 1) * 32 + hi * 16)); } while (0)
#define VLDN(H, F) do { F[0] = vtr(vp0 + vso + v_rd_off((H) & 3, (H) >> 2, 0)); F[1] = vtr(vp0 + vso + v_rd_off((H) & 3, (H) >> 2, 1)); } while (0)
#define PSWAP(A0, A1, B0, B1, OUT) do { auto r0_ = __builtin_amdgcn_permlane32_swap(A0, B0, false, false); auto r1_ = __builtin_amdgcn_permlane32_swap(A1, B1, false, false); \
    u32x4 w_ = {r0_[0], r1_[0], r0_[1], r1_[1]}; OUT = __builtin_bit_cast(bf16x8, w_); } while (0)
#define HALF0(P0) do { sum0 = 0.f; _Pragma("unroll") for (int r = 0; r < 16; ++r) sum0 += P0[r]; \
    { unsigned a0_ = cvtpk(P0[0], P0[1]), a1_ = cvtpk(P0[2], P0[3]), b0_ = cvtpk(P0[4], P0[5]), b1_ = cvtpk(P0[6], P0[7]); PSWAP(a0_, a1_, b0_, b1_, pa0); } \
    { unsigned a0_ = cvtpk(P0[8], P0[9]), a1_ = cvtpk(P0[10], P0[11]), b0_ = cvtpk(P0[12], P0[13]), b1_ = cvtpk(P0[14], P0[15]); PSWAP(a0_, a1_, b0_, b1_, pa1); } } while (0)
#define MASKB(P0, P1, T, ON) do { const int dr_ = R0 + (T) - rq + 7; int x_ = 4 * hi + rot - cq; asm volatile("" : "+v"(x_));     \
    const float* tb_ = tab + dr_ * 31 + 15 + x_; const int y_ = (ON) ? (x_ + cq - cs) : 4096; \
    float bb_[24];     \
    _Pragma("unroll") for (int r = 0; r < 16; ++r) bb_[r] = tb_[(r & 3) + 8 * (r >> 2)]; \
    _Pragma("unroll") for (int r = 0; r < 8; ++r) bb_[16 + r] = tb_[(r & 3) + 8 * (r >> 2) + 32]; \
    _Pragma("unroll") for (int r = 0; r < 24; ++r) asm volatile("" : "+v"(bb_[r])); \
    _Pragma("unroll") for (int r = 0; r < 16; ++r) { const int kr_ = (r & 3) + 8 * (r >> 2); \
      P0[r] = ((unsigned)(kr_ + y_) < 16u) ? P0[r] + bb_[r] : -INFINITY; if (r < 8) P1[r] = ((unsigned)(kr_ + 32 + y_) < 16u) ? P1[r] + bb_[16 + r] : -INFINITY; } } while (0)
#define QK_PLAIN(P0, P1, KSO) do { const int kso = (KSO); bf16x8 kf[5]; KLDN(0, kf[0]); KLDN(1, kf[1]); KLDN(2, kf[2]); KLDN(3, kf[3]); SBAR(); \
    _Pragma("unroll") for (int g = 0; g < 16; ++g) { const int d = g >> 1; if (g + 4 < 16) KLDN(g + 4, kf[(g + 4) % 5]); \
      if ((g & 1) == 0) P0 = __builtin_amdgcn_mfma_f32_32x32x16_bf16(kf[g % 5], qr[d], (d == 0) ? negm : P0, 0, 0, 0); \
      else              P1 = __builtin_amdgcn_mfma_f32_32x32x16_bf16(kf[g % 5], qr[d], (d == 0) ? negm : P1, 0, 0, 0); SBAR(); } } while (0)
#define PV_GAP(h) do { if ((h) + 3 < 12) VLDN((h) + 3, vf[((h) + 3) & 3]); \
      { const bf16x8 vb_ = (bf16x8){vf[(h) & 3][0][0], vf[(h) & 3][0][1], vf[(h) & 3][0][2], vf[(h) & 3][0][3], vf[(h) & 3][1][0], vf[(h) & 3][1][1], vf[(h) & 3][1][2], vf[(h) & 3][1][3]}; \
        const bf16x8 pa_ = ((h) >> 2) == 0 ? pa0 : ((h) >> 2) == 1 ? pa1 : pa2; \
        o[(h) & 3] = __builtin_amdgcn_mfma_f32_32x32x16_bf16(pa_, vb_, o[(h) & 3], 0, 0, 0); } } while (0)
#define FIN1(PC1) do { EXP16(PC1); float s_ = sum0; _Pragma("unroll") for (int r = 0; r < 16; ++r) s_ += PC1[r]; \
    auto rr_ = __builtin_amdgcn_permlane32_swap(__float_as_uint(s_), __float_as_uint(s_), false, false); l_reg += __uint_as_float(rr_[0]) + __uint_as_float(rr_[1]); \
    { unsigned a0_ = cvtpk(PC1[0], PC1[1]), a1_ = cvtpk(PC1[2], PC1[3]), b0_ = cvtpk(PC1[4], PC1[5]), b1_ = cvtpk(PC1[6], PC1[7]); PSWAP(a0_, a1_, b0_, b1_, pa2); } \
    { unsigned a0_ = cvtpk(PC1[8], PC1[9]), a1_ = cvtpk(PC1[10], PC1[11]), b0_ = cvtpk(PC1[12], PC1[13]), b1_ = cvtpk(PC1[14], PC1[15]); PSWAP(a0_, a1_, b0_, b1_, pa3); } } while (0)
#define STEP(PC0, PC1, PN0, PN1, j) do { \
    if ((j) + 2 < NT) WAIT_BAR4(); else WAIT_BAR0(); if ((j) + 3 < NT) DMA_T((j) + 3, s3); \
    const bool aC_ = ((j) >= t_lo) && ((j) < t_lo + 8), aN_ = ((j) + 1 < NT) && ((j) + 1 >= t_lo) && ((j) + 1 < t_lo + 8); \
    const int vso = s0 * SHM_V; \
    if (aC_) {     \
      const int kso = s1 * SHM_KN; bf16x8 kf[5]; s16x4 vf[4][2]; unsigned ca0, ca1, cb0, cb1; float sumA = sum0; \
      SBAR(); KLDN(0, kf[0]); KLDN(1, kf[1]); KLDN(2, kf[2]); KLDN(3, kf[3]); SBAR(); \
      _Pragma("unroll") for (int g = 0; g < 16; ++g) { const int d = g >> 1; \
        if (g + 4 < 16) KLDN(g + 4, kf[(g + 4) % 5]); \
        if (g == 13) { VLDN(0, vf[0]); } if (g == 14) { VLDN(1, vf[1]); } if (g == 15) { VLDN(2, vf[2]); } \
        if ((g & 1) == 0) PN0 = __builtin_amdgcn_mfma_f32_32x32x16_bf16(kf[g % 5], qr[d], (d == 0) ? negm : PN0, 0, 0, 0); \
        else              PN1 = __builtin_amdgcn_mfma_f32_32x32x16_bf16(kf[g % 5], qr[d], (d == 0) ? negm : PN1, 0, 0, 0); \
        if (g < 4) { PC1[2 * g] = __builtin_amdgcn_exp2f(PC1[2 * g]); PC1[2 * g + 1] = __builtin_amdgcn_exp2f(PC1[2 * g + 1]); if (g >= 1) { sumA += PC1[2 * g - 2]; sumA += PC1[2 * g - 1]; } PIN(PC1); PIN(sumA); } \
        if (g == 4) { sumA += PC1[6]; sumA += PC1[7]; PIN(sumA); } \
        if (g == 5) { ca0 = cvtpk(PC1[0], PC1[1]); ca1 = cvtpk(PC1[2], PC1[3]); } \
        if (g == 6) { cb0 = cvtpk(PC1[4], PC1[5]); cb1 = cvtpk(PC1[6], PC1[7]); } \
        if (g == 7) { PSWAP(ca0, ca1, cb0, cb1, pa2); PIN(pa2); } \
        if (g == 8) { auto rr_ = __builtin_amdgcn_permlane32_swap(__float_as_uint(sumA), __float_as_uint(sumA), false, false); \
                      l_reg += __uint_as_float(rr_[0]) + __uint_as_float(rr_[1]); PIN(l_reg); } \
        SBAR(); } \
      sum0 = 0.f; SBAR(); \
      _Pragma("unroll") for (int h = 0; h < 12; ++h) { \
        PV_GAP(h); \
        if (h >= 4 && h < 12) { PN0[2 * h - 8] = __builtin_amdgcn_exp2f(PN0[2 * h - 8]); PN0[2 * h - 7] = __builtin_amdgcn_exp2f(PN0[2 * h - 7]); if (h >= 5) { sum0 += PN0[2 * h - 10]; sum0 += PN0[2 * h - 9]; } PIN(PN0); PIN(sum0); } \
        if (h == 8) { ca0 = cvtpk(PN0[0], PN0[1]); ca1 = cvtpk(PN0[2], PN0[3]); } \
        if (h == 9) { cb0 = cvtpk(PN0[4], PN0[5]); cb1 = cvtpk(PN0[6], PN0[7]); } \
        if (h == 10) { PSWAP(ca0, ca1, cb0, cb1, pa0); PIN(pa0); } \
        SBAR(); \
        if (h == 3) { MASKB(PN0, PN1, (j) + 1, aN_); NEWMAX(PN0, PN1, false); SBAR(); } } \
      sum0 += PN0[14]; sum0 += PN0[15]; \
      ca0 = cvtpk(PN0[8], PN0[9]); ca1 = cvtpk(PN0[10], PN0[11]); cb0 = cvtpk(PN0[12], PN0[13]); cb1 = cvtpk(PN0[14], PN0[15]); PSWAP(ca0, ca1, cb0, cb1, pa1); \
      RESC(); \
    } else if (aN_) { \
      QK_PLAIN(PN0, PN1, s1 * SHM_KN); MASKB(PN0, PN1, (j) + 1, true); NEWMAX(PN0, PN1, true); EXP16(PN0); HALF0(PN0); \
    } \
    s0 = (s0 + 1) & 3; s1 = (s1 + 1) & 3; s3 = (s3 + 1) & 3; } while (0)
  int s0 = 0, s1 = 1, s3 = 3;
  WAIT_BAR4();
  if (t_lo == 0) { QK_PLAIN(pA0, pA1, 0); MASKB(pA0, pA1, 0, true); NEWMAX(pA0, pA1, true); EXP16(pA0); HALF0(pA0); }
  int j = 0;
  for (; j + 1 < NT; j += 2) { STEP(pA0, pA1, pB0, pB1, j); STEP(pB0, pB1, pA0, pA1, j + 1); }
  if (j < NT) { STEP(pA0, pA1, pB0, pB1, j); }
  if (hi == 0) li_l[r32] = l_reg; asm volatile("s_waitcnt lgkmcnt(0)" ::: "memory");
  float rli[16];
#pragma unroll
  for (int r = 0; r < 16; ++r) rli[r] = __builtin_amdgcn_rcpf(li_l[crow(r, hi)]);
  { unsigned zr[16][4];
#pragma unroll
    for (int r = 0; r < 16; ++r) { const long trow = wid * QBLK + crow(r, hi);
#pragma unroll
      for (int d0 = 0; d0 < 4; ++d0) zr[r][d0] = Zp[trow * LDZ + d0 * 32 + r32]; }
    asm volatile("s_waitcnt vmcnt(0)" ::: "memory"); SBAR();
#pragma unroll
    for (int r = 0; r < 16; ++r) { const long trow = wid * QBLK + crow(r, hi);
#pragma unroll
      for (int d0 = 0; d0 < 4; ++d0) { const float z = bf2f(zr[r][d0]); const float v = o[d0][r] * rli[r];
        const float g = v * z * __builtin_amdgcn_rcpf(1.f + __expf(-z));
        Op[((size_t)(d0 >> 1) * M_TOK + trow) * 64 + (d0 & 1) * 32 + r32] = (bf16_t)f2bf(g); } } }
  asm volatile("s_waitcnt vmcnt(0) lgkmcnt(0)\n\ts_barrier" ::: "memory");
#undef DMA_T
#undef MX3
#undef WAIT_BAR0
#undef WAIT_BAR4
#undef NEWMAX
#undef RESC
#undef EXP16
#undef PIN
#undef KLDN
#undef VLDN
#undef PSWAP
#undef HALF0
#undef MASKB
#undef QK_PLAIN
#undef PV_GAP
#undef FIN1
#undef STEP
}
#undef SBAR
}

__device__ __forceinline__ void wt_item(const float* __restrict__ W, int ldw, int K, int src_c0, bf16_t* __restrict__ WT, int dst_r0, int k0, LAS float* scr, int lane, int Ndst) {
#pragma unroll 32
    for (int i = 0; i < 32; ++i) { const int kk = 2 * i + (lane >> 5); scr[kk * 33 + (lane & 31)] = (src_c0 >= 0) ? W[(size_t)(k0 + kk) * ldw + src_c0 + (lane & 31)] : 0.f; }
    LDS_WAIT(); asm volatile("" ::: "memory");
    const int c = lane & 7;
#pragma unroll
    for (int j = 0; j < 4; ++j) { const int n = (lane >> 3) + 8 * j; const LAS float* s = scr + (8 * c) * 33 + n;
        v4u o; o.x = pk2(s[0 * 33], s[1 * 33]); o.y = pk2(s[2 * 33], s[3 * 33]); o.z = pk2(s[4 * 33], s[5 * 33]); o.w = pk2(s[6 * 33], s[7 * 33]);
        *(v4u*)(WT + ((size_t)(k0 >> 6) * Ndst + dst_r0 + n) * 64 + 8 * c) = o; }
    LDS_WAIT(); asm volatile("" ::: "memory");
}
__device__ __forceinline__ void conv_plain(const float* W, int K, int N, bf16_t* WT, LAS float* scr, int gw, int NGW, int lane) {
    const int nblk = N / 32, items = (K / 64) * nblk;
    for (int it = gw; it < items; it += NGW) { const int kb = it / nblk, nb = it % nblk; wt_item(W, N, K, nb * 32, WT, nb * 32, kb * 64, scr, lane, N); }
}
__device__ __forceinline__ void conv_mla_win(const float* W, bf16_t* WT, LAS float* scr, int gw, int NGW, int lane) {
    constexpr int nblk = MLA_NP / 32, items = (DM / 64) * nblk;
    for (int it = gw; it < items; it += NGW) { const int kb = it / nblk, nb = it % nblk;
        const int src = nb < 32 ? nb * 32 : nb < 96 ? 1088 + (nb - 32) * 32 : nb < 98 ? 1024 + (nb - 96) * 32 : -1;
        wt_item(W, 3136, DM, src, WT, nb * 32, kb * 64, scr, lane, MLA_NP); }
}
__device__ __forceinline__ void conv_generic(const float* W, int ldw, int K, int Ndst, bool win_map, bf16_t* WT, LAS float* scr, int gw, int NGW, int lane) {
    const int nblk = Ndst / 32, items = (K / 64) * nblk;
    for (int it = gw; it < items; it += NGW) { const int kb = it / nblk, nb = it % nblk; int src = nb * 32;
        if (win_map) src = nb < 32 ? nb * 32 : nb < 96 ? 1088 + (nb - 32) * 32 : nb < 98 ? 1024 + (nb - 96) * 32 : -1;
        wt_item(W, ldw, K, src, WT, nb * 32, kb * 64, scr, lane, Ndst); }
}
__device__ const double INV_FREQ[32] = {1.0, 0.7498942093324559, 0.5623413251903491, 0.4216965034285822, 0.31622776601683794, 0.23713737056616552, 0.1778279410038923, 0.1333521432163324,
    0.1, 0.07498942093324558, 0.05623413251903491, 0.042169650342858224, 0.03162277660168379, 0.023713737056616554, 0.01778279410038923, 0.01333521432163324,
    0.01, 0.007498942093324558, 0.005623413251903491, 0.004216965034285823, 0.0031622776601683794, 0.0023713737056616554, 0.0017782794100389228, 0.001333521432163324,
    0.001, 0.0007498942093324559, 0.0005623413251903491, 0.00042169650342858224, 0.00031622776601683794, 0.00023713737056616554, 0.00017782794100389227, 0.0001333521432163324};
__device__ __forceinline__ void rope_entry(int idx, float* cs, float* sn) {
    const int pos = idx >> 5, i = idx & 31;
    const double ang = (double)pos * INV_FREQ[i];
    const double k = __builtin_rint(ang * 0.15915494309189535);
    const double r = (ang - k * 6.283185307179586) - k * 2.4492935982947064e-16;
    const double r2 = r * r;
    double s = 1.0 / 51090942171709440000.0, c = 1.0 / 2432902008176640000.0;
    s = s * r2 - 1.0 / 121645100408832000.0;  c = c * r2 - 1.0 / 6402373705728000.0;
    s = s * r2 + 1.0 / 355687428096000.0;     c = c * r2 + 1.0 / 20922789888000.0;
    s = s * r2 - 1.0 / 1307674368000.0;       c = c * r2 - 1.0 / 87178291200.0;
    s = s * r2 + 1.0 / 6227020800.0;          c = c * r2 + 1.0 / 479001600.0;
    s = s * r2 - 1.0 / 39916800.0;            c = c * r2 - 1.0 / 3628800.0;
    s = s * r2 + 1.0 / 362880.0;              c = c * r2 + 1.0 / 40320.0;
    s = s * r2 - 1.0 / 5040.0;                c = c * r2 - 1.0 / 720.0;
    s = s * r2 + 1.0 / 120.0;                 c = c * r2 + 1.0 / 24.0;
    s = s * r2 - 1.0 / 6.0;                   c = c * r2 - 0.5;
    s = s * r2 + 1.0;                         c = c * r2 + 1.0;
    s = s * r;
    cs[idx] = (float)c; sn[idx] = (float)s;
}
constexpr int RPW = 2;
template <int MODE>
__device__ __forceinline__ void row_pass(const float* __restrict__ xin, float* __restrict__ xres, const bf16_t* __restrict__ y, const float* __restrict__ gpost,
                                         const float* __restrict__ gpre, bf16_t* __restrict__ h, int gw, int NGW, int lane) {
    for (int m = RPW * gw; m < M_TOK; m += RPW * NGW) {
        f32x4 xv[RPW][8]; v2u yy[RPW][8];
#pragma unroll
        for (int rr = 0; rr < RPW; ++rr) {
            const float* xr = ((MODE == 0 || xin != nullptr) ? xin : xres) + (size_t)(m + rr) * DM + lane * 4;
#pragma unroll
            for (int k = 0; k < 8; ++k) xv[rr][k] = *(const f32x4*)(xr + k * 256);
            if (MODE >= 1) { const bf16_t* yr = y + (size_t)(m + rr) * 256 + lane * 4;
#pragma unroll
                for (int k = 0; k < 8; ++k) yy[rr][k] = *(const v2u*)(yr + (size_t)k * ((size_t)M_TOK * 256)); }
        }
        if (MODE >= 1) {
            float rstd[RPW];
#pragma unroll
            for (int rr = 0; rr < RPW; ++rr) { float s = 0.f;
#pragma unroll
                for (int k = 0; k < 8; ++k)
#pragma unroll
                    for (int e = 0; e < 2; ++e) { const float a = bf2f(yy[rr][k][e] & 0xffffu), b = bf2f(yy[rr][k][e] >> 16); s += a * a + b * b; }
                rstd[rr] = 1.0f / sqrtf(wave_sum(s) * (1.f / DM) + RMS_EPS); }
#pragma unroll
            for (int k = 0; k < 8; ++k) { const f32x4 g = *(const f32x4*)(gpost + k * 256 + lane * 4);
#pragma unroll
                for (int rr = 0; rr < RPW; ++rr) { f32x4 yv;
                    yv[0] = bf2f(yy[rr][k][0] & 0xffffu); yv[1] = bf2f(yy[rr][k][0] >> 16); yv[2] = bf2f(yy[rr][k][1] & 0xffffu); yv[3] = bf2f(yy[rr][k][1] >> 16);
                    xv[rr][k] += yv * rstd[rr] * g; } }
        }
        if (MODE != 0)
#pragma unroll
        for (int rr = 0; rr < RPW; ++rr) { float* xo = xres + (size_t)(m + rr) * DM + lane * 4;
#pragma unroll
            for (int k = 0; k < 8; ++k) *(f32x4*)(xo + k * 256) = xv[rr][k]; }
        if (MODE <= 1) {
            float rstd[RPW];
#pragma unroll
            for (int rr = 0; rr < RPW; ++rr) { float s = 0.f;
#pragma unroll
                for (int k = 0; k < 8; ++k) s += (xv[rr][k][0] * xv[rr][k][0] + xv[rr][k][1] * xv[rr][k][1]) + (xv[rr][k][2] * xv[rr][k][2] + xv[rr][k][3] * xv[rr][k][3]);
                rstd[rr] = 1.0f / sqrtf(wave_sum(s) * (1.f / DM) + RMS_EPS); }
#pragma unroll
            for (int k = 0; k < 8; ++k) { const f32x4 g = *(const f32x4*)(gpre + k * 256 + lane * 4);
#pragma unroll
                for (int rr = 0; rr < RPW; ++rr) { const f32x4 a = xv[rr][k] * rstd[rr] * g;
                    v2u o; o.x = pk2(a[0], a[1]); o.y = pk2(a[2], a[3]);
                    *(v2u*)(h + ((size_t)(k * 4 + (lane >> 4)) * M_TOK + (m + rr)) * 64 + (lane & 15) * 4) = o; } }
        }
    }
}
__device__ __forceinline__ void mla_mid(const bf16_t* __restrict__ wino, const float* __restrict__ gq, const float* __restrict__ gkv, const float* __restrict__ cs_tab, const float* __restrict__ sn_tab,
                                        bf16_t* __restrict__ cqn, bf16_t* __restrict__ ckvn, bf16_t* __restrict__ kr, int gw, int NGW, int lane) {
    const f32x4 gq0 = *(const f32x4*)(gq + lane * 8), gq1 = *(const f32x4*)(gq + lane * 8 + 4), gk0 = *(const f32x4*)(gkv + lane * 8), gk1 = *(const f32x4*)(gkv + lane * 8 + 4);
    for (int m0 = 4 * gw; m0 < M_TOK; m0 += 4 * NGW) {
        v4u v[4][2]; unsigned w[4]; float cc[4], ss[4];
#pragma unroll
        for (int rr = 0; rr < 4; ++rr) { const bf16_t* row = wino + (size_t)(m0 + rr) * 256; constexpr size_t TS = (size_t)M_TOK * 256;
            v[rr][0] = *(const v4u*)(row + (size_t)(lane >> 5) * TS + (lane & 31) * 8); v[rr][1] = *(const v4u*)(row + (size_t)(2 + (lane >> 5)) * TS + (lane & 31) * 8);
            w[rr] = *(const unsigned*)(row + 12 * TS + 2 * (lane & 31));
            const int pos = (m0 + rr) & (SEQ - 1); cc[rr] = cs_tab[pos * 32 + (lane & 31)]; ss[rr] = sn_tab[pos * 32 + (lane & 31)]; }
#pragma unroll
        for (int rr = 0; rr < 4; ++rr) { const int m = m0 + rr;
#pragma unroll
            for (int part = 0; part < 2; ++part) {
                float f[8]; float s = 0.f;
#pragma unroll
                for (int e = 0; e < 4; ++e) { f[2 * e] = bf2f(v[rr][part][e] & 0xffffu); f[2 * e + 1] = bf2f(v[rr][part][e] >> 16); s += f[2 * e] * f[2 * e] + f[2 * e + 1] * f[2 * e + 1]; }
                const float rstd = 1.0f / sqrtf(wave_sum(s) * (1.f / LORA) + RMS_EPS);
                const f32x4 g0 = part == 0 ? gq0 : gk0, g1 = part == 0 ? gq1 : gk1;
                v4u o; o.x = pk2(f[0] * rstd * g0[0], f[1] * rstd * g0[1]); o.y = pk2(f[2] * rstd * g0[2], f[3] * rstd * g0[3]);
                o.z = pk2(f[4] * rstd * g1[0], f[5] * rstd * g1[1]); o.w = pk2(f[6] * rstd * g1[2], f[7] * rstd * g1[3]);
                *(v4u*)((part == 0 ? cqn : ckvn) + ((size_t)(lane >> 3) * M_TOK + m) * 64 + (lane & 7) * 8) = o;
            }
            if (lane < 32) { const float x1 = bf2f(w[rr] & 0xffffu), x2 = bf2f(w[rr] >> 16);
                *(unsigned*)(kr + (size_t)m * 64 + 2 * lane) = pk2(x1 * cc[rr] - x2 * ss[rr], x1 * ss[rr] + x2 * cc[rr]); }
        }
    }
}

typedef __attribute__((address_space(1))) unsigned gu32;
#define XB_TMO      128
#define XB_XCNT(j)  (256  + 64 * (j))
#define XB_XSUB(j)  (1280 + 64 * (j))
#define XB_XGEN(j)  (2304 + 64 * (j))
#define XB_TOP      3328
#define XB_TOPGEN   3392
#define XCD_BAR_WORDS 3456
#define XB_SPIN_CAP (1u << 18)

__device__ __forceinline__ unsigned xb_ld(unsigned* p)              { return __hip_atomic_load(p, __ATOMIC_RELAXED, __HIP_MEMORY_SCOPE_AGENT); }
__device__ __forceinline__ unsigned xb_add(unsigned* p, unsigned v) { return __hip_atomic_fetch_add(p, v, __ATOMIC_RELAXED, __HIP_MEMORY_SCOPE_AGENT); }
__device__ __forceinline__ unsigned xb_xcc_id() { return (unsigned)__builtin_amdgcn_s_getreg((3 << 11) | 20) & 0xFu; }
#define XB_SPIN(cond, bar) do { unsigned _sp = 0; while (cond) { __builtin_amdgcn_s_sleep(1); \
    if ((++_sp & 255u) == 0u) { if (xb_ld(&(bar)[XB_TMO])) break; if (_sp > XB_SPIN_CAP) { atomicAdd(&(bar)[XB_TMO], 1u); break; } } } } while (0)

struct XcdBarrier {
    unsigned* bar; unsigned x;
    volatile LAS unsigned* st;
};

__device__ __forceinline__ XcdBarrier xcd_barrier_post(unsigned* bar, volatile LAS unsigned* st) {
    XcdBarrier b; b.bar = bar; b.x = xb_xcc_id(); b.st = st;
    if (threadIdx.x == 0) (void)xb_add(&bar[XB_XCNT(b.x)], 1u);
    return b;
}
__device__ __forceinline__ void xcd_barrier_complete(unsigned* bar, unsigned x, unsigned& nloc, unsigned& nx) {
    const unsigned G = gridDim.x * gridDim.y * gridDim.z;
    unsigned sum, cnt, mine, sp = 0u;
    for (;;) {
        sum = 0u; cnt = 0u; mine = 0u;
#pragma unroll
        for (unsigned j = 0; j < 16; ++j) { const unsigned c = xb_ld(&bar[XB_XCNT(j)]); sum += c; cnt += (c > 0u) ? 1u : 0u; mine = (j == x) ? c : mine; }
        if (sum == G) break;
        __builtin_amdgcn_s_sleep(1);
        if ((++sp & 255u) == 0u) { if (xb_ld(&bar[XB_TMO])) break; if (sp > XB_SPIN_CAP) { atomicAdd(&bar[XB_TMO], 1u); break; } }
    }
    nloc = mine > 0u ? mine : 1u; nx = cnt > 0u ? cnt : 1u;
}

__device__ __forceinline__ void xcd_barrier(const XcdBarrier& b) {
    asm volatile("s_waitcnt vmcnt(0)" ::: "memory");
    __syncthreads();
    if (threadIdx.x == 0) {
        unsigned* bar = b.bar;
        __builtin_amdgcn_s_waitcnt(0);
        unsigned nloc = b.st[0], nx = b.st[1];
        if (nloc == 0u) { xcd_barrier_complete(bar, b.x, nloc, nx); b.st[0] = nloc; b.st[1] = nx; }
        const unsigned old = xb_add(&bar[XB_XSUB(b.x)], 1u);
        const unsigned gen = old / nloc;
        if (old + 1u == (gen + 1u) * nloc) {
            __builtin_amdgcn_fence(__ATOMIC_RELEASE, "agent");
            asm volatile("s_waitcnt vmcnt(0)" ::: "memory");
            const unsigned og = xb_add(&bar[XB_TOP], 1u);
            const unsigned tg = og / nx;
            if (og + 1u == (tg + 1u) * nx) xb_add(&bar[XB_TOPGEN], 1u);
            else XB_SPIN(xb_ld(&bar[XB_TOPGEN]) == tg, bar);
            __builtin_amdgcn_fence(__ATOMIC_ACQUIRE, "agent");
            xb_add(&bar[XB_XGEN(b.x)], 1u);
            asm volatile("s_waitcnt vmcnt(0)" ::: "memory");
        } else {
            XB_SPIN(xb_ld(&bar[XB_XGEN(b.x)]) == gen, bar);
            __builtin_amdgcn_fence(__ATOMIC_ACQUIRE, "agent");
            asm volatile("s_waitcnt vmcnt(0)" ::: "memory");
        }
    }
    __syncthreads();
}

__device__ const unsigned char PH_KIND[21]  = {0, 1, 2, 1, 4,  1, 5, 1, 3, 1, 4,  1, 2, 1, 4,  1, 5, 1, 3, 1, 4};
__device__ const unsigned char PH_LAYER[21] = {0, 0, 0, 0, 0,  1, 1, 1, 1, 1, 1,  2, 2, 2, 2,  3, 3, 3, 3, 3, 3};
__device__ const unsigned char PH_SUB[21]   = {0, 0, 1, 2, 3,  0, 1, 2, 3, 4, 5,  0, 1, 2, 3,  0, 1, 2, 3, 4, 5};
constexpr int LDS_BYTES = 147456;
constexpr int NPHASES = 21;
struct Args { const float* in[12]; float* out; unsigned char* ws; int ph_lo, ph_hi; };
static_assert(sizeof(Args) == 12 * 8 + 8 + 8 + 8, "no padding");

__global__ void __launch_bounds__(NWAVES * 64, 2) fwd_mega(Args args) {
    extern __shared__ __attribute__((aligned(16))) unsigned char lds[];
    cg::grid_group grid = cg::this_grid();
    XcdBarrier bar; bar.bar = (unsigned*)args.ws; bar.x = 0; bar.st = nullptr;
    if (args.ph_hi - args.ph_lo > 2) {
        volatile LAS unsigned* MISC = (volatile LAS unsigned*)((LAS unsigned char*)lds + LDS_BYTES - 128);
        if (threadIdx.x < 32) MISC[threadIdx.x] = 0u;
        __syncthreads();
        bar = xcd_barrier_post((unsigned*)args.ws, MISC + 8);
    }
    const int G = gridDim.x, bx = blockIdx.x;
    const int vcu = (G % 8 == 0) ? (bx % 8) * (G / 8) + bx / 8 : bx;
    const int NGW = G * NWAVES;
    if (EN_PRO && args.ph_lo == 0) {
        const int tid = opaque_tid(), lane = tid & 63, wave = __builtin_amdgcn_readfirstlane(tid >> 6), gw = vcu * NWAVES + wave;
        LAS float* scr = (LAS float*)((LAS unsigned char*)lds + wave * 16384);
        unsigned char* ws = args.ws;
        const float* x_in = args.in[0]; const float* norm_pre = args.in[1];
        const float* na_w_in = args.in[3]; const float* na_w_out = args.in[5];
        const float* mla_w_in = args.in[6]; const float* mla_w_q_b = args.in[8]; const float* mla_w_kv_b = args.in[10]; const float* mla_w_out = args.in[11];
        float* xres = args.out;
        float* cs_tab = (float*)(ws + WS_COS); float* sn_tab = (float*)(ws + WS_SIN);
        bf16_t* A_WIN = (bf16_t*)(ws + WS_A_WIN); bf16_t* A_WOUT = (bf16_t*)(ws + WS_A_WOUT);
        bf16_t* B_WIN = (bf16_t*)(ws + WS_B_WIN); bf16_t* B_WIN2 = (bf16_t*)(ws + WS_B_WIN2); bf16_t* B_WQB = (bf16_t*)(ws + WS_B_WQB); bf16_t* B_WKVB = (bf16_t*)(ws + WS_B_WKVB); bf16_t* B_WOUT = (bf16_t*)(ws + WS_B_WOUT);
        bf16_t* H = (bf16_t*)(ws + WS_H);
        for (int rc_ = 0; rc_ < REP_CONV; ++rc_) {
        conv_plain(na_w_in, DM, NA_N, A_WIN, scr, gw, NGW, lane);
        conv_plain(na_w_out, DM, DM, A_WOUT, scr, gw, NGW, lane);
        conv_mla_win(mla_w_in, B_WIN, scr, gw, NGW, lane);
        conv_plain(mla_w_q_b, LORA, QB_N, B_WQB, scr, gw, NGW, lane);
        conv_plain(mla_w_kv_b, LORA, KVB_N, B_WKVB, scr, gw, NGW, lane);
        conv_plain(mla_w_out, DM, DM, B_WOUT, scr, gw, NGW, lane);
        }
        for (int i = gw * 64 + lane; i < SEQ * 32; i += NGW * 64) rope_entry(i, cs_tab, sn_tab);
        row_pass<0>(x_in, xres, nullptr, nullptr, norm_pre, H, gw, NGW, lane);
    }
    for (int ph = args.ph_lo; ph < args.ph_hi; ++ph) {
        if (ph > args.ph_lo) { for (int rs_ = 0; rs_ < REP_SYNC; ++rs_) { if (ph == args.ph_lo + 1) grid.sync(); else xcd_barrier(bar); } }
        const int tid = opaque_tid(), lane = tid & 63, wave = __builtin_amdgcn_readfirstlane(tid >> 6), gw = vcu * NWAVES + wave;
        LAS float* scr = (LAS float*)((LAS unsigned char*)lds + wave * 16384);
        int zz = 0; asm volatile("" : "+s"(zz));
        unsigned char* ws = args.ws + zz;
        const float* x_in = args.in[0 + zz]; const float* norm_pre = args.in[1 + zz]; const float* norm_post = args.in[2 + zz];
        const float* na_w_in = args.in[3 + zz]; const float* na_rpb = args.in[4 + zz]; const float* na_w_out = args.in[5 + zz];
        const float* mla_w_in = args.in[6 + zz]; const float* mla_q_norm = args.in[7 + zz]; const float* mla_w_q_b = args.in[8 + zz];
        const float* mla_kv_norm = args.in[9 + zz]; const float* mla_w_kv_b = args.in[10 + zz]; const float* mla_w_out = args.in[11 + zz];
        float* xres = args.out + zz;
        float* cs_tab = (float*)(ws + WS_COS); float* sn_tab = (float*)(ws + WS_SIN);
        bf16_t* A_WIN = (bf16_t*)(ws + WS_A_WIN); bf16_t* A_WOUT = (bf16_t*)(ws + WS_A_WOUT);
        bf16_t* B_WIN = (bf16_t*)(ws + WS_B_WIN); bf16_t* B_WIN2 = (bf16_t*)(ws + WS_B_WIN2); bf16_t* B_WQB = (bf16_t*)(ws + WS_B_WQB); bf16_t* B_WKVB = (bf16_t*)(ws + WS_B_WKVB); bf16_t* B_WOUT = (bf16_t*)(ws + WS_B_WOUT);
        bf16_t* H = (bf16_t*)(ws + WS_H); bf16_t* QKVZ = (bf16_t*)(ws + WS_QKVZ); bf16_t* WINO = (bf16_t*)(ws + WS_WINO);
        bf16_t* QB = (bf16_t*)(ws + WS_Q); bf16_t* KVB = (bf16_t*)(ws + WS_KV); bf16_t* CQN = (bf16_t*)(ws + WS_CQN); bf16_t* CKVN = (bf16_t*)(ws + WS_CKVN);
        bf16_t* KR = (bf16_t*)(ws + WS_KR); bf16_t* Y = (bf16_t*)(ws + WS_Y);

        const int kind = PH_KIND[ph], layer = PH_LAYER[ph], sub = PH_SUB[ph];
        const int jl = layer >> 1; const bool is_mla = layer & 1;
        int conv_set = -1, cgw = gw, cNGW = NGW;

        if (kind == 0) {
        } else if (EN_GEMM && kind == 1) {
            const int ng = (is_mla && sub == 2) ? 2 : 1;
            for (int gi = 0; gi < ng * REP_GEMM; ++gi) {
                const bf16_t* A; const bf16_t* Bt; bf16_t* O; int N, K;
                if (!is_mla) { if (sub == 0) { A = H; Bt = A_WIN; O = QKVZ; N = NA_N; K = DM; } else { A = H; Bt = A_WOUT; O = Y; N = DM; K = DM; } }
                else { if (sub == 0) { A = H; Bt = (layer == 3) ? B_WIN2 : B_WIN; O = WINO; N = MLA_NP; K = DM; }
                       else if (sub == 2) { if ((gi % ng) == 0) { A = CQN; Bt = B_WQB; O = QB; N = QB_N; K = LORA; } else { A = CKVN; Bt = B_WKVB; O = KVB; N = KVB_N; K = LORA; } }
                       else { A = H; Bt = B_WOUT; O = Y; N = DM; K = DM; } }
                pg8::Gemm g{A, Bt, M_TOK, N, K}; pg8::StaticOrder S; S.init(M_TOK, N, G, bx);
                const bool tm_ = !(is_mla && sub == 2 && (gi % ng) == 0);
                pg8::EpiBf16<0> E{O, tm_ ? 256 : N, nullptr, tm_ ? 256 : 0, tm_ ? (size_t)M_TOK * 256 : (size_t)0, 1.f};
                pg8::gemm_phase<pg8::EpiBf16<0>, pg8::StaticOrder, true, true>((LAS unsigned char*)lds, g, S, E);
                if (is_mla && sub == 0) {
                    if (G != 256) conv_set = (layer == 1) ? 0 : 2;
                    else if (bx >= 64) { conv_set = (layer == 1) ? 0 : 2; cgw = (bx - 64) * NWAVES + wave; cNGW = (G - 64) * NWAVES; }
                }
            }
        } else if (EN_NA && kind == 2) {
            for (int rep = 0; rep < REP_NA; ++rep) for (int u = vcu; u < 1024; u += G) {
                const int bh = u >> 5, rg = u & 31, b = bh >> 4, h = bh & 15, r0row = rg * 4;
                const int R0 = min(max(r0row - 4, 0), 120), last = min(max(r0row - 1, 0), 120) + 7, NT = last - R0 + 1;
                const size_t tok0 = (size_t)b * SEQ + r0row * 64, key0 = (size_t)b * SEQ + R0 * 64;
                const size_t TS = (size_t)M_TOK * 256; const bf16_t* hb = QKVZ + (size_t)(h >> 1) * TS + (h & 1) * 128;
                att::na_unit3((char*)lds, hb + tok0 * 256, hb + 8 * TS + key0 * 256, hb + 16 * TS + key0 * 256,
                             hb + 24 * TS + tok0 * 256, H + ((size_t)(2 * h) * M_TOK + tok0) * 64, NT, R0, r0row, na_rpb + (size_t)(jl * 16 + h) * 465);
            }
        } else if (EN_MLA && kind == 3) {
            for (int rep = 0; rep < REP_MLA; ++rep) for (int u = vcu; u < 1024; u += G) {
                const int bh = u >> 5, qb = u & 31, b = bh >> 4, h = bh & 15;
                const size_t tok0 = (size_t)b * SEQ + qb * 256, key0 = (size_t)b * SEQ;
                const int un = (u + G < 1024) ? u + G : u, bhn = un >> 5; const size_t keyn = (size_t)(bhn >> 4) * SEQ; const int hn = bhn & 15;
                const size_t TS = (size_t)M_TOK * 256;
                att::mla_unit((char*)lds, QB + tok0 * QB_N + h * 192, KVB + h * TS + key0 * 256, KVB + h * TS + key0 * 256 + 128, KR + key0 * 64,
                              WINO + (size_t)(4 + (h >> 1)) * TS + tok0 * 256 + (h & 1) * 128, H + ((size_t)(2 * h) * M_TOK + tok0) * 64, SEQ / 64, cs_tab, sn_tab, qb * 256,
                              KVB + hn * TS + keyn * 256, KVB + hn * TS + keyn * 256 + 128, KR + keyn * 64, u == vcu, u + G < 1024);
            }
        } else if (EN_ROW && kind == 4) {
            const float* gpost = norm_post + layer * DM;
            if (layer == DEPTH - 1) row_pass<2>(nullptr, xres, Y, gpost, nullptr, nullptr, gw, NGW, lane);
            else {
                row_pass<1>(layer == 0 ? x_in : nullptr, xres, Y, gpost, norm_pre + (layer + 1) * DM, H, gw, NGW, lane);
            }
        } else if (EN_MID) {
            for (int rm_ = 0; rm_ < REP_MID; ++rm_) mla_mid(WINO, mla_q_norm + jl * LORA, mla_kv_norm + jl * LORA, cs_tab, sn_tab, CQN, CKVN, KR, gw, NGW, lane);
        }
        if (conv_set >= 0) {
            const int nmat = 3;
            for (int mi = 0; mi < nmat; ++mi) {
                const float* W; bf16_t* WT; int ldw, K, Nd; bool wm = false;
                if (conv_set == 0) { if (mi == 0) { W = na_w_in + (size_t)DM * NA_N; WT = A_WIN; ldw = NA_N; K = DM; Nd = NA_N; } else if (mi == 1) { W = na_w_out + (size_t)DM * DM; WT = A_WOUT; ldw = DM; K = DM; Nd = DM; }
                                     else { W = mla_w_in + (size_t)DM * 3136; WT = B_WIN2; ldw = 3136; K = DM; Nd = MLA_NP; wm = true; } }
                else { if (mi == 0) { W = mla_w_q_b + (size_t)LORA * QB_N; WT = B_WQB; ldw = QB_N; K = LORA; Nd = QB_N; }
                       else if (mi == 1) { W = mla_w_kv_b + (size_t)LORA * KVB_N; WT = B_WKVB; ldw = KVB_N; K = LORA; Nd = KVB_N; }
                       else { W = mla_w_out + (size_t)DM * DM; WT = B_WOUT; ldw = DM; K = DM; Nd = DM; } }
                conv_generic(W, ldw, K, Nd, wm, WT, scr, cgw, cNGW, lane);
            }
        }
    }
}

#ifndef MK_PER_PHASE
#define MK_PER_PHASE 0
#endif
extern "C" void kernel_launch(void* const* d_in, const int* in_sizes, int n_in, void* d_out, int out_size, void* d_ws, size_t ws_size, hipStream_t stream) {
    static int grid = 0;
    if (grid == 0) {
        if (n_in != 12 || in_sizes[0] != M_TOK * DM || out_size != M_TOK * DM || ws_size < WS_END) {
            fprintf(stderr, "kernel_launch: unexpected shapes: n_in %d in0 %d out %d ws %zu (need %zu)\n", n_in, n_in > 0 ? in_sizes[0] : -1, out_size, ws_size, (size_t)WS_END); grid = -1; return; }
        int dev = 0, cus = 0, per_cu = 0;
        hipGetDevice(&dev); hipDeviceGetAttribute(&cus, hipDeviceAttributeMultiprocessorCount, dev);
        if (hipFuncSetAttribute((const void*)fwd_mega, hipFuncAttributeMaxDynamicSharedMemorySize, LDS_BYTES) != hipSuccess) { fprintf(stderr, "kernel_launch: hipFuncSetAttribute failed\n"); grid = -1; return; }
        if (hipOccupancyMaxActiveBlocksPerMultiprocessor(&per_cu, (const void*)fwd_mega, NWAVES * 64, LDS_BYTES) != hipSuccess || per_cu < 1) { fprintf(stderr, "kernel_launch: occupancy query says %d\n", per_cu); per_cu = 1; }
        (void)hipGetLastError();
        grid = cus * per_cu;
    }
    if (grid < 0) return;
    if (hipMemsetAsync(d_ws, 0, 16384, stream) != hipSuccess) { fprintf(stderr, "kernel_launch: memset failed\n"); return; }
    Args a{};
    for (int i = 0; i < 12; ++i) a.in[i] = (const float*)d_in[i];
    a.out = (float*)d_out; a.ws = (unsigned char*)d_ws;
#if MK_PER_PHASE
    for (int ph = 0; ph < NPHASES; ++ph) {
        a.ph_lo = ph; a.ph_hi = ph + 1; void* kargs[] = {&a};
        hipError_t e = hipLaunchCooperativeKernel((const void*)fwd_mega, dim3(grid), dim3(NWAVES * 64), kargs, LDS_BYTES, stream);
        if (e != hipSuccess) { fprintf(stderr, "kernel_launch: cooperative launch (phase %d) failed: %s (grid %d)\n", ph, hipGetErrorString(e), grid); break; }
    }
#else
    a.ph_lo = 0; a.ph_hi = NPHASES; void* kargs[] = {&a};
    hipError_t e = hipLaunchCooperativeKernel((const void*)fwd_mega, dim3(grid), dim3(NWAVES * 64), kargs, LDS_BYTES, stream);
    if (e != hipSuccess) fprintf(stderr, "kernel_launch: cooperative launch failed: %s (grid %d)\n", hipGetErrorString(e), grid);
#endif
}
```

```cpp
#include <hip/hip_runtime.h>
#include <hip/hip_cooperative_groups.h>
#include <cstdio>
#include <cstdint>
namespace cg = cooperative_groups;
__device__ __forceinline__ int opaque_tid() { int t = threadIdx.x; asm volatile("" : "+v"(t)); return t; }
namespace pg8 {
#define PG8_LAS __attribute__((address_space(3)))
typedef unsigned short bf16_t;
typedef short bf16x8 __attribute__((ext_vector_type(8)));
typedef float f32x4 __attribute__((ext_vector_type(4)));
typedef unsigned u32x4 __attribute__((ext_vector_type(4)));
constexpr int BM = 256, BK = 64, HALF = 128, HTB = HALF * BK * 2  , STAGE_BYTES = 8 * HTB, NXCD = 8, WGM = 8;

__host__ __device__ __forceinline__ int lds_byte(int r, int c) { const int st = (r >> 4) * 2 + (c >> 5), rr = r & 15, cc = c & 31, ob = rr * 64 + cc * 2; return st * 1024 + (ob ^ (((ob >> 9) & 1) << 5)); }
__host__ __device__ __forceinline__ void stage_rc(int b, int& R, int& C) { const int st = b / 1024, sb = b % 1024, swz = sb ^ (((sb >> 9) & 1) << 5); R = (st >> 1) * 16 + swz / 64; C = (st & 1) * 32 + (swz % 64) / 2; }
__host__ __device__ __forceinline__ int perm32(int rho) { const int n = rho >> 4, i = rho & 15; return 8 * (i >> 2) + 4 * n + (i & 3); }

struct Unit { int pm, pn; };
struct Gemm { const bf16_t* A; const bf16_t* Bt; int M, N, K; };

struct StaticOrder {
    int nM, nN, nwg, G, c;
    __host__ __device__ void init(int M, int N, int G_, int c_) { nM = M / BM; nN = N / BM; nwg = nM * nN; G = G_; c = c_; }
    __host__ __device__ bool next(int i, Unit& u) const {
        const long L = (long)i * G + c; if (L >= nwg) return false;
        int wgid = (int)L; { const int q = nwg / NXCD, r = nwg % NXCD, xcd = wgid % NXCD, off = wgid / NXCD; wgid = (xcd < r ? xcd * (q + 1) : r * (q + 1) + (xcd - r) * q) + off; }
        const int nig = WGM * nN, gid = wgid / nig, fm = gid * WGM, gsz = (nM - fm) < WGM ? (nM - fm) : WGM;
        u.pm = fm + ((wgid % nig) % gsz); u.pn = (wgid % nig) / gsz; return true;
    }
    __device__ __forceinline__ void a_ready(const Unit&) const {}
    __device__ __forceinline__ void done(const Unit&) const {}
};

__device__ __forceinline__ unsigned cvt_pk_bf16(float lo, float hi) { unsigned r; asm volatile("v_cvt_pk_bf16_f32 %0, %1, %2" : "=v"(r) : "v"(lo), "v"(hi)); return r; }
typedef float f32x2 __attribute__((ext_vector_type(2)));
__device__ __forceinline__ f32x2 gelu_pk(f32x2 v) {
    const f32x2 av = __builtin_elementwise_abs(v), d = av * 0.2316418882f + 1.0f;
    f32x2 t; t.x = __builtin_amdgcn_rcpf(d.x); t.y = __builtin_amdgcn_rcpf(d.y);
    f32x2 q = t * 0.5307027145f + (-0.7265760135f); q = q * t + 0.7107068705f; q = q * t + (-0.142248368f); q = q * t + 0.127414796f; q = q * t;
    const f32x2 s = (v * v) * (-0.72134752044f);
    f32x2 e; e.x = __builtin_amdgcn_exp2f(s.x); e.y = __builtin_amdgcn_exp2f(s.y);
    const f32x2 m = v * (q * e), r = v - m;
    f32x2 o; o.x = v.x < 0.f ? m.x : r.x; o.y = v.y < 0.f ? m.y : r.y; return o;
}

template <int ACT  > struct EpiBf16 {
    static constexpr bool PERM = true, AFTER_DRAIN = false; static_assert(ACT == 0 || ACT == 1, "EpiBf16: ACT is 0 (none) or 1 (gelu_pk)");
    bf16_t* O; int ldc; const float* bias; int split_cols; size_t split_stride; float scale0;
    __device__ __forceinline__ void operator()(const f32x4 (&acc)[2][2][4][2], const Unit& u, int wr, int wc, int fr, int fq) const {
        const int row0 = u.pm * BM + wr * 64 + fr; int colt = u.pn * BM; bf16_t* base = O;
        float sc = 1.f; if (split_cols) { const int t = colt / split_cols; base += (size_t)t * split_stride; colt -= t * split_cols; if (t == 0) sc = scale0; }
        const int col0 = colt + wc * 32 + 8 * fq, bcol0 = u.pn * BM + wc * 32 + 8 * fq;
        f32x4 bv[2][2];
#pragma unroll
        for (int bj = 0; bj < 2; ++bj)
#pragma unroll
            for (int n = 0; n < 2; ++n) bv[bj][n] = bias ? *(const f32x4*)(bias + bcol0 + bj * HALF + 4 * n) : (f32x4){0.f, 0.f, 0.f, 0.f};
#pragma unroll
        for (int ai = 0; ai < 2; ++ai)
#pragma unroll
            for (int m = 0; m < 4; ++m) { bf16_t* rowp = base + (size_t)(row0 + ai * HALF + m * 16) * ldc + col0;
#pragma unroll
                for (int bj = 0; bj < 2; ++bj) { f32x4 v0 = acc[ai][bj][m][0] + bv[bj][0], v1 = acc[ai][bj][m][1] + bv[bj][1];
                    if (ACT == 1) { f32x2 a = gelu_pk((f32x2){v0[0], v0[1]}), b = gelu_pk((f32x2){v0[2], v0[3]}), c = gelu_pk((f32x2){v1[0], v1[1]}), d = gelu_pk((f32x2){v1[2], v1[3]});
                        v0 = (f32x4){a.x, a.y, b.x, b.y}; v1 = (f32x4){c.x, c.y, d.x, d.y}; }
                    v0 = v0 * sc; v1 = v1 * sc; u32x4 w; w.x = cvt_pk_bf16(v0[0], v0[1]); w.y = cvt_pk_bf16(v0[2], v0[3]); w.z = cvt_pk_bf16(v1[0], v1[1]); w.w = cvt_pk_bf16(v1[2], v1[3]);
                    *(u32x4*)(rowp + bj * HALF) = w; } }
    }
};
template <class Epi, class Sched, bool ALIGN_EPI = false, bool SP2 = false>
__device__ __forceinline__ void gemm_phase(PG8_LAS unsigned char* lds, const Gemm g, const Sched& S, const Epi& E) {
    const int tid = opaque_tid(), wid = __builtin_amdgcn_readfirstlane(tid >> 6), lane = tid & 63, wr = wid >> 2, wc = wid & 3, fr = lane & 15, fq = lane >> 4;
    const int K = g.K, nt = K / BK;
    unsigned voffA[2], voffB[2];
#pragma unroll
    for (int i = 0; i < 2; ++i) { int R, C; stage_rc(tid * 16 + i * 8192, R, C); const int Rb = Epi::PERM ? ((R & ~31) + perm32(R & 31)) : R;
        voffA[i] = (unsigned)(R * K + C) * 2u; voffB[i] = (unsigned)(Rb * BK + C) * 2u; }
    const size_t kstep = (size_t)(BK * 2);
    const size_t hstep = (size_t)HALF * K * 2;
    const size_t tstep = 2 * hstep;
    const size_t kstepB = (size_t)g.N * BK * 2, hstepB = (size_t)HALF * BK * 2, tstepB = 2 * hstepB;
    const unsigned ldsw = (unsigned)wid * 1024u;
    const int aoff = lds_byte(wr * 64 + fr, fq * 8), boff = lds_byte(wc * 32 + fr, fq * 8);
#define PG8_SA(b, h) (((b) * 2 + (h)) * HTB)
#define PG8_SB(b, h) ((4 + (b) * 2 + (h)) * HTB)
#define PG8_STAGE(bufoff, gbase, voff) do { _Pragma("unroll") for (int _i = 0; _i < 2; ++_i) \
        __builtin_amdgcn_global_load_lds((const unsigned*)((const char*)(gbase) + (voff)[_i]), (PG8_LAS unsigned*)(lds + (bufoff) + ldsw + _i * 8192), 16, 0, 0); } while (0)
#define PG8_LDA(dst, b, h) do { _Pragma("unroll") for (int m = 0; m < 4; ++m) _Pragma("unroll") for (int k = 0; k < 2; ++k) dst[m][k] = *(const PG8_LAS bf16x8*)(lds + PG8_SA(b, h) + aoff + m * 2048 + k * 1024); } while (0)
#define PG8_LDB(dst, b, h) do { _Pragma("unroll") for (int n = 0; n < 2; ++n) _Pragma("unroll") for (int k = 0; k < 2; ++k) dst[n][k] = *(const PG8_LAS bf16x8*)(lds + PG8_SB(b, h) + boff + n * 2048 + k * 1024); } while (0)
#define PG8_MMA(ai, bj, At, Bt) do { __builtin_amdgcn_s_setprio(1); _Pragma("unroll") for (int m = 0; m < 4; ++m) _Pragma("unroll") for (int n = 0; n < 2; ++n) _Pragma("unroll") for (int k = 0; k < 2; ++k) \
        acc[ai][bj][m][n] = __builtin_amdgcn_mfma_f32_16x16x32_bf16(Bt[n][k], At[m][k], acc[ai][bj][m][n], 0, 0, 0); __builtin_amdgcn_s_setprio(0); } while (0)
#define PG8_WAIT_V(n) asm volatile("s_waitcnt vmcnt(" #n ")" ::: "memory")
#define PG8_WAIT_L(n) asm volatile("s_waitcnt lgkmcnt(" #n ")" ::: "memory")
#define PG8_BAR __builtin_amdgcn_s_barrier()
#define PG8_SCHED __builtin_amdgcn_sched_barrier(0)
    Unit cur, nxt; int ui = 0;
    if (!S.next(0, cur)) return;
    f32x4 acc[2][2][4][2];
#pragma unroll
    for (int a = 0; a < 2; ++a)
#pragma unroll
        for (int b = 0; b < 2; ++b)
#pragma unroll
            for (int m = 0; m < 4; ++m)
#pragma unroll
                for (int n = 0; n < 2; ++n) acc[a][b][m][n] = (f32x4){0.f, 0.f, 0.f, 0.f};
    bf16x8 At[4][2], B0[2][2], B1[2][2];
    const char* cA = (const char*)g.A + (size_t)cur.pm * tstep; const char* cB = (const char*)g.Bt + (size_t)cur.pn * tstepB;
    S.a_ready(cur);
    if constexpr (SP2) {
        PG8_STAGE(PG8_SB(0, 0), cB, voffB); PG8_STAGE(PG8_SB(0, 1), cB + hstepB, voffB); PG8_STAGE(PG8_SA(0, 0), cA, voffA); PG8_STAGE(PG8_SA(0, 1), cA + hstep, voffA);
        if (wr == 1) PG8_BAR;
        PG8_WAIT_V(2); PG8_BAR;
        PG8_STAGE(PG8_SB(1, 0), cB + kstepB, voffB); PG8_STAGE(PG8_SA(1, 0), cA + kstep, voffA); PG8_STAGE(PG8_SB(1, 1), cB + hstepB + kstepB, voffB);
        PG8_WAIT_V(6); PG8_BAR;
    } else {
        PG8_STAGE(PG8_SB(0, 0), cB, voffB); PG8_STAGE(PG8_SA(0, 0), cA, voffA); PG8_STAGE(PG8_SB(0, 1), cB + hstepB, voffB); PG8_STAGE(PG8_SA(0, 1), cA + hstep, voffA);
        if (wr == 1) PG8_BAR;
        PG8_WAIT_V(4); PG8_BAR;
        PG8_STAGE(PG8_SB(1, 0), cB + kstepB, voffB); PG8_STAGE(PG8_SA(1, 0), cA + kstep, voffA); PG8_STAGE(PG8_SB(1, 1), cB + hstepB + kstepB, voffB);
        PG8_WAIT_V(6); PG8_BAR;
    }
    for (;;) {
        const bool has_next = S.next(ui + 1, nxt);
        const char* nA = has_next ? (const char*)g.A + (size_t)nxt.pm * tstep : cA; const char* nB = has_next ? (const char*)g.Bt + (size_t)nxt.pn * tstepB : cB;
        for (int t = 0; t < nt; t += 2) {
            const bool last = (t == nt - 2);
            const char* a1 = cA + (size_t)(t + 1) * kstep;
            const char* a2 = last ? nA : cA + (size_t)(t + 2) * kstep; const char* b2 = last ? nB : cB + (size_t)(t + 2) * kstepB;
            const char* a3 = a2 + kstep; const char* b3 = b2 + kstepB;
            if (last && has_next) S.a_ready(nxt);
            if constexpr (SP2) {
            PG8_LDB(B0, 0, 0); PG8_LDB(B1, 0, 1); PG8_SCHED; PG8_LDA(At, 0, 0); PG8_STAGE(PG8_SA(1, 1), a1 + hstep, voffA);
            PG8_WAIT_V(8); PG8_WAIT_L(0); PG8_BAR; PG8_MMA(0, 0, At, B0); PG8_MMA(0, 1, At, B1); PG8_BAR; PG8_SCHED;
            PG8_LDA(At, 0, 1); PG8_STAGE(PG8_SB(0, 0), b2, voffB); PG8_STAGE(PG8_SB(0, 1), b2 + hstepB, voffB); PG8_STAGE(PG8_SA(0, 0), a2, voffA);
            PG8_WAIT_V(8); PG8_WAIT_L(0); PG8_BAR; PG8_MMA(1, 0, At, B0); PG8_MMA(1, 1, At, B1); PG8_BAR; PG8_SCHED;
            PG8_LDB(B0, 1, 0); PG8_LDB(B1, 1, 1); PG8_SCHED; PG8_LDA(At, 1, 0); PG8_STAGE(PG8_SA(0, 1), a2 + hstep, voffA);
            PG8_WAIT_V(8); PG8_WAIT_L(0); PG8_BAR; PG8_MMA(0, 0, At, B0); PG8_MMA(0, 1, At, B1); PG8_BAR; PG8_SCHED;
            PG8_LDA(At, 1, 1); PG8_STAGE(PG8_SB(1, 0), b3, voffB); PG8_STAGE(PG8_SB(1, 1), b3 + hstepB, voffB); PG8_STAGE(PG8_SA(1, 0), a3, voffA);
            PG8_WAIT_V(8); PG8_WAIT_L(0); PG8_BAR; PG8_MMA(1, 0, At, B0); PG8_MMA(1, 1, At, B1); PG8_BAR; PG8_SCHED;
            } else {
            PG8_LDB(B0, 0, 0); PG8_SCHED; PG8_LDA(At, 0, 0); PG8_STAGE(PG8_SA(1, 1), a1 + hstep, voffA);
            PG8_WAIT_L(8); PG8_BAR; PG8_WAIT_L(0); PG8_MMA(0, 0, At, B0); PG8_BAR; PG8_SCHED;
            PG8_LDB(B1, 0, 1); PG8_STAGE(PG8_SB(0, 0), b2, voffB);
            PG8_BAR; PG8_WAIT_L(0); PG8_MMA(0, 1, At, B1); PG8_BAR;
            PG8_LDA(At, 0, 1); PG8_STAGE(PG8_SA(0, 0), a2, voffA);
            PG8_BAR; PG8_WAIT_L(0); PG8_MMA(1, 0, At, B0); PG8_BAR; PG8_SCHED;
            PG8_STAGE(PG8_SB(0, 1), b2 + hstepB, voffB);
            PG8_WAIT_V(6); PG8_BAR; PG8_MMA(1, 1, At, B1); PG8_BAR;
            PG8_LDB(B0, 1, 0); PG8_SCHED; PG8_LDA(At, 1, 0); PG8_STAGE(PG8_SA(0, 1), a2 + hstep, voffA);
            PG8_WAIT_L(8); PG8_BAR; PG8_WAIT_L(0); PG8_MMA(0, 0, At, B0); PG8_BAR; PG8_SCHED;
            PG8_LDB(B1, 1, 1); PG8_STAGE(PG8_SB(1, 0), b3, voffB);
            PG8_BAR; PG8_WAIT_L(0); PG8_MMA(0, 1, At, B1); PG8_BAR;
            PG8_LDA(At, 1, 1); PG8_STAGE(PG8_SA(1, 0), a3, voffA);
            PG8_BAR; PG8_WAIT_L(0); PG8_MMA(1, 0, At, B0); PG8_BAR; PG8_SCHED;
            PG8_STAGE(PG8_SB(1, 1), b3 + hstepB, voffB);
            PG8_WAIT_V(6); PG8_BAR; PG8_MMA(1, 1, At, B1); PG8_BAR;
            }
        }
        if constexpr (ALIGN_EPI) { if (wr == 0) PG8_BAR; }
        if constexpr (!Epi::AFTER_DRAIN) { E(acc, cur, wr, wc, fr, fq); S.done(cur); }
        if (!has_next) break;
#pragma unroll
        for (int a = 0; a < 2; ++a)
#pragma unroll
            for (int b = 0; b < 2; ++b)
#pragma unroll
                for (int m = 0; m < 4; ++m)
#pragma unroll
                    for (int n = 0; n < 2; ++n) acc[a][b][m][n] = (f32x4){0.f, 0.f, 0.f, 0.f};
        cur = nxt; cA = nA; cB = nB; ++ui;
        if constexpr (ALIGN_EPI) { if (wr == 1) PG8_BAR; }
    }
    PG8_WAIT_V(0);
    if constexpr (!ALIGN_EPI) { if (wr == 0) PG8_BAR; }
    PG8_BAR;
    if constexpr (Epi::AFTER_DRAIN) { E.fused(acc, cur, wr, wc, fr, fq, lds, wid, lane); S.done(cur); }
#undef PG8_SA
#undef PG8_SB
#undef PG8_STAGE
#undef PG8_LDA
#undef PG8_LDB
#undef PG8_MMA
#undef PG8_WAIT_V
#undef PG8_WAIT_L
#undef PG8_BAR
#undef PG8_SCHED
}
}
#ifndef REP_CONV
#define REP_CONV 1
#endif
#ifndef REP_MID
#define REP_MID 1
#endif
#ifndef REP_SYNC
#define REP_SYNC 1
#endif
#ifndef REP_NA
#define REP_NA 1
#endif
#ifndef REP_MLA
#define REP_MLA 1
#endif
#ifndef REP_GEMM
#define REP_GEMM 1
#endif
#ifndef EN_GEMM
#define EN_GEMM 1
#endif
#ifndef EN_NA
#define EN_NA 1
#endif
#ifndef EN_MLA
#define EN_MLA 1
#endif
#ifndef EN_ROW
#define EN_ROW 1
#endif
#ifndef EN_PRO
#define EN_PRO 1
#endif
#ifndef EN_MID
#define EN_MID 1
#endif

constexpr int SEQ = 8192, BATCH = 2, DM = 2048, M_TOK = BATCH * SEQ, DEPTH = 4;
constexpr int NA_N = 8192, MLA_NP = 3328  , QB_N = 3072, KVB_N = 4096, LORA = 512;
constexpr float RMS_EPS = 1e-6f;
constexpr int NWAVES = 8;
#define LAS __attribute__((address_space(3)))
typedef unsigned short bf16_t;
typedef unsigned v4u __attribute__((ext_vector_type(4)));
typedef unsigned v2u __attribute__((ext_vector_type(2)));
typedef float f32x4 __attribute__((ext_vector_type(4)));

__device__ __forceinline__ float bf2f(unsigned h) { return __uint_as_float(h << 16); }
__device__ __forceinline__ unsigned f2bf(float f) { unsigned u = __float_as_uint(f); return (u + 0x7fffu + ((u >> 16) & 1u)) >> 16; }
__device__ __forceinline__ unsigned pk2(float lo, float hi) { return f2bf(lo) | (f2bf(hi) << 16); }
__device__ __forceinline__ float wave_sum(float v) {
    v += __uint_as_float(__builtin_amdgcn_mov_dpp(__float_as_uint(v), 0xB1, 0xF, 0xF, true));
    v += __uint_as_float(__builtin_amdgcn_mov_dpp(__float_as_uint(v), 0x4E, 0xF, 0xF, true));
    v += __uint_as_float(__builtin_amdgcn_mov_dpp(__float_as_uint(v), 0x141, 0xF, 0xF, true));
    v += __uint_as_float(__builtin_amdgcn_mov_dpp(__float_as_uint(v), 0x140, 0xF, 0xF, true));
    { auto rr = __builtin_amdgcn_permlane16_swap(__float_as_uint(v), __float_as_uint(v), false, false); v = __uint_as_float(rr[0]) + __uint_as_float(rr[1]); }
    { auto rr = __builtin_amdgcn_permlane32_swap(__float_as_uint(v), __float_as_uint(v), false, false); v = __uint_as_float(rr[0]) + __uint_as_float(rr[1]); }
    return v;
}
#define LDS_WAIT() asm volatile("s_waitcnt lgkmcnt(0)" ::: "memory")

constexpr size_t MiB = 1u << 20;
constexpr size_t WS_COS = 1 * MiB, WS_SIN = 2 * MiB;
constexpr size_t WS_A_WIN = 4 * MiB, WS_A_WOUT = 36 * MiB;
constexpr size_t WS_B_WIN = 44 * MiB, WS_B_WQB = 57 * MiB, WS_B_WKVB = 60 * MiB, WS_B_WOUT = 64 * MiB;
constexpr size_t WS_H = 72 * MiB;
constexpr size_t WS_BIG = 136 * MiB;
constexpr size_t WS_QKVZ = WS_BIG;
constexpr size_t WS_WINO = WS_BIG, WS_Q = 240 * MiB, WS_KV = 336 * MiB, WS_CQN = 464 * MiB, WS_CKVN = 480 * MiB, WS_KR = 496 * MiB;
constexpr size_t WS_Y = WS_BIG;
constexpr size_t WS_B_WIN2 = 498 * MiB;
constexpr size_t WS_END = 511 * MiB;

namespace att {
using bf16x8 = __attribute__((ext_vector_type(8))) short;
using s16x4  = __attribute__((ext_vector_type(4))) short;
using f32x16 = __attribute__((ext_vector_type(16))) float;
using u32x4  = __attribute__((ext_vector_type(4))) unsigned;
constexpr int NW = 8, QBLK = 32, KVBLK = 64;
constexpr int SHM_V = 16384, SHM_KN = 16384, SHM_KR = 8192;
constexpr int L_V = 0, L_KN = 2 * SHM_V, L_KR = L_KN + 2 * SHM_KN, L_WS = L_KR + 2 * SHM_KR, L_RPB = L_WS + NW * 64 * 4, L_END = L_RPB + 4096;
#define KSWZ(row, colB) ((row) * 256 + ((colB) ^ (((row) & 15) << 4)))
#define RSWZ(row, colB) ((row) * 128 + ((colB) ^ ((((row) >> 1) & 7) << 4)))
#define SBAR() __builtin_amdgcn_sched_barrier(0)
__device__ __forceinline__ int crow(int r, int hi) { return (r & 3) + 8 * (r >> 2) + 4 * hi; }
__device__ __forceinline__ unsigned cvtpk(float lo, float hi) {
  unsigned r; asm volatile("v_cvt_pk_bf16_f32 %0, %1, %2" : "=v"(r) : "v"(lo), "v"(hi)); return r;
}
constexpr float THR = 8.f;
__device__ __forceinline__ void partialSM(f32x16& p0, f32x16& p1, float& m_reg, float& mn, float& alpha, const float C, const float THRS) {
  float pmax = p0[0];
#pragma unroll
  for (int r = 1; r < 16; ++r) pmax = fmaxf(pmax, p0[r]);
#pragma unroll
  for (int r = 0; r < 16; ++r) pmax = fmaxf(pmax, p1[r]);
  { auto rr = __builtin_amdgcn_permlane32_swap(__float_as_uint(pmax), __float_as_uint(pmax), false, false);
    pmax = fmaxf(__uint_as_float(rr[0]), __uint_as_float(rr[1])); }
  if (__builtin_expect(__all(pmax - m_reg <= THRS), 1)) { mn = m_reg; alpha = 1.f; }
  else { mn = fmaxf(m_reg, pmax); alpha = __builtin_amdgcn_exp2f((m_reg - mn) * C); m_reg = mn; }
  float mnC = -mn * C;
#pragma unroll
  for (int r = 0; r < 16; ++r) p0[r] = fmaf(p0[r], C, mnC);
#pragma unroll
  for (int r = 0; r < 16; ++r) p1[r] = fmaf(p1[r], C, mnC);
#pragma unroll
  for (int r = 0; r < 16; ++r) p0[r] = __builtin_amdgcn_exp2f(p0[r]);
}
__device__ __forceinline__ void finishSM(f32x16& p0, f32x16& p1, float alpha, float& l_reg, bf16x8& pa0, bf16x8& pa1, bf16x8& pa2, bf16x8& pa3) {
#pragma unroll
  for (int r = 0; r < 16; ++r) p1[r] = __builtin_amdgcn_exp2f(p1[r]);
  float ps = 0;
#pragma unroll
  for (int r = 0; r < 16; ++r) ps += p0[r];
#pragma unroll
  for (int r = 0; r < 16; ++r) ps += p1[r];
  { auto rr = __builtin_amdgcn_permlane32_swap(__float_as_uint(ps), __float_as_uint(ps), false, false);
    ps = __uint_as_float(rr[0]) + __uint_as_float(rr[1]); }
  l_reg = l_reg * alpha + ps;
#define PK4(P, BASE, OUT) do { unsigned a0 = cvtpk(P[BASE + 0], P[BASE + 1]), a1 = cvtpk(P[BASE + 2], P[BASE + 3]);   \
    unsigned b0 = cvtpk(P[BASE + 4], P[BASE + 5]), b1 = cvtpk(P[BASE + 6], P[BASE + 7]);                              \
    auto r0 = __builtin_amdgcn_permlane32_swap(a0, b0, false, false); auto r1 = __builtin_amdgcn_permlane32_swap(a1, b1, false, false); \
    u32x4 w = {r0[0], r1[0], r0[1], r1[1]}; OUT = *reinterpret_cast<bf16x8*>(&w); } while (0)
  PK4(p0, 0, pa0); PK4(p0, 8, pa1); PK4(p1, 0, pa2); PK4(p1, 8, pa3);
#undef PK4
}
__device__ __forceinline__ int v_st(int k, int c) { const int kk = (k & ~0xC) | ((k & 4) << 1) | ((k & 8) >> 1); return ((kk >> 3) * 4 + (c >> 5)) * 512 + ((kk & 7) * 32 + (c & 31)) * 2; }
__device__ __forceinline__ int v_rd_base(int lane) { return ((lane & 3) << 3) | (((lane >> 2) & 3) << 6) | (((lane >> 4) & 1) << 5) | (((lane >> 5) & 1) << 8); }
constexpr int v_rd_off(int d0, int ks, int half) { return d0 * 512 + ks * 4096 + half * 2048; }
template <int OFF> __device__ __forceinline__ s16x4 tr_read(int vb) {
  s16x4 r; asm volatile("ds_read_b64_tr_b16 %0, %1 offset:%2" : "=&v"(r) : "v"(vb), "i"(OFF) : "memory"); return r;
}
template <int D0> __device__ __forceinline__ void pv_one(f32x16& od, int vb, bf16x8 pa0, bf16x8 pa1, bf16x8 pa2, bf16x8 pa3) {
  const s16x4 l0 = tr_read<v_rd_off(D0, 0, 0)>(vb), h0 = tr_read<v_rd_off(D0, 0, 1)>(vb), l1 = tr_read<v_rd_off(D0, 1, 0)>(vb), h1 = tr_read<v_rd_off(D0, 1, 1)>(vb);
  const s16x4 l2 = tr_read<v_rd_off(D0, 2, 0)>(vb), h2 = tr_read<v_rd_off(D0, 2, 1)>(vb), l3 = tr_read<v_rd_off(D0, 3, 0)>(vb), h3 = tr_read<v_rd_off(D0, 3, 1)>(vb);
  asm volatile("s_waitcnt lgkmcnt(0)" ::: "memory"); SBAR();
#define PK(L, H) (bf16x8){L[0], L[1], L[2], L[3], H[0], H[1], H[2], H[3]}
  od = __builtin_amdgcn_mfma_f32_32x32x16_bf16(pa0, PK(l0, h0), od, 0, 0, 0);
  od = __builtin_amdgcn_mfma_f32_32x32x16_bf16(pa1, PK(l1, h1), od, 0, 0, 0);
  od = __builtin_amdgcn_mfma_f32_32x32x16_bf16(pa2, PK(l2, h2), od, 0, 0, 0);
  od = __builtin_amdgcn_mfma_f32_32x32x16_bf16(pa3, PK(l3, h3), od, 0, 0, 0);
#undef PK
}
__device__ __forceinline__ void pv_d0(f32x16* o, int vb, bf16x8 pa0, bf16x8 pa1, bf16x8 pa2, bf16x8 pa3) {
  pv_one<0>(o[0], vb, pa0, pa1, pa2, pa3); pv_one<1>(o[1], vb, pa0, pa1, pa2, pa3); pv_one<2>(o[2], vb, pa0, pa1, pa2, pa3); pv_one<3>(o[3], vb, pa0, pa1, pa2, pa3);
}

template <bool MLA>
__device__ __forceinline__ void attn_unit(char* lds, const bf16_t* __restrict__ Qp, const bf16_t* __restrict__ Knp, const bf16_t* __restrict__ Vp,
                                          const bf16_t* __restrict__ Krp, const bf16_t* __restrict__ Zp, bf16_t* __restrict__ Op, const int NT,
                                          const int R0, const int r0row, const float* __restrict__ rpb_h,
                                          const float* __restrict__ cs_tab, const float* __restrict__ sn_tab, const int pos0) {
  constexpr int LDQ = MLA ? QB_N : NA_N, LDK = MLA ? KVB_N : NA_N, LDZ = MLA ? MLA_NP : NA_N, NQ = MLA ? 12 : 8;
  constexpr float SCALE = MLA ? 0.07216878364870322f : 0.08838834764831845f;
  constexpr float C = SCALE * 1.4426950408889634f, THRS = THR / SCALE;
  const int tid = opaque_tid(), wid = __builtin_amdgcn_readfirstlane(tid >> 6), lane = tid & 63, r32 = lane & 31, hi = lane >> 5;
  float* wsf = (float*)(lds + L_WS) + wid * 64; float* li_l = wsf; float* al_l = wsf + 32;
  float* tab = (float*)(lds + L_RPB) + 256;
  float m_reg = -1e30f, l_reg = 0.f; f32x16 o[4] = {}; bf16x8 qr[NQ];
  const bf16_t* Qw = Qp + (long)(wid * QBLK + r32) * LDQ + hi * 8;
#pragma unroll
  for (int d0 = 0; d0 < 8; ++d0) qr[d0] = *reinterpret_cast<const bf16x8*>(Qw + d0 * 16);
  if constexpr (MLA) {
    const int pos = pos0 + wid * QBLK + r32;
#pragma unroll
    for (int d0 = 0; d0 < 4; ++d0) {
      const u32x4 raw = *reinterpret_cast<const u32x4*>(Qw + 128 + d0 * 16);
      const int i0 = d0 * 8 + hi * 4;
      const f32x4 cc = *reinterpret_cast<const f32x4*>(cs_tab + pos * 32 + i0), ss = *reinterpret_cast<const f32x4*>(sn_tab + pos * 32 + i0);
      u32x4 w;
#pragma unroll
      for (int p = 0; p < 4; ++p) { const float x1 = bf2f(raw[p] & 0xffffu), x2 = bf2f(raw[p] >> 16); w[p] = cvtpk(x1 * cc[p] - x2 * ss[p], x1 * ss[p] + x2 * cc[p]); }
      qr[8 + d0] = *reinterpret_cast<bf16x8*>(&w);
    }
  } else {
    for (int i = tid; i < 15 * 31; i += NW * 64) tab[i] = rpb_h[i] * (1.0f / SCALE);
  }
  const int sr = tid >> 4, sc = (tid & 15) * 8, vst0 = v_st(sr, sc), vst1 = v_st(32 + sr, sc);
  const int krow = tid >> 3, kcol = (tid & 7) * 8;
  const int vb0 = (int)(uintptr_t)(lds + L_V) + v_rd_base(lane);
  bf16x8 vs0, vs1, ks0, ks1, kr0;
#define SLOAD(k0) do { vs0 = *reinterpret_cast<const bf16x8*>(&Vp[(long)((k0) + sr) * LDK + sc]); vs1 = *reinterpret_cast<const bf16x8*>(&Vp[(long)((k0) + 32 + sr) * LDK + sc]); \
    ks0 = *reinterpret_cast<const bf16x8*>(&Knp[(long)((k0) + sr) * LDK + sc]); ks1 = *reinterpret_cast<const bf16x8*>(&Knp[(long)((k0) + 32 + sr) * LDK + sc]); \
    if constexpr (MLA) kr0 = *reinterpret_cast<const bf16x8*>(&Krp[(long)((k0) + krow) * 64 + kcol]); } while (0)
#define SWRITE(b) do { *(bf16x8*)(lds + L_V + (b) * SHM_V + vst0) = vs0; *(bf16x8*)(lds + L_V + (b) * SHM_V + vst1) = vs1; \
    *(bf16x8*)(lds + L_KN + (b) * SHM_KN + KSWZ(sr, sc * 2)) = ks0; *(bf16x8*)(lds + L_KN + (b) * SHM_KN + KSWZ(32 + sr, sc * 2)) = ks1; \
    if constexpr (MLA) *(bf16x8*)(lds + L_KR + (b) * SHM_KR + RSWZ(krow, kcol * 2)) = kr0; } while (0)
  const int rq = r0row + (wid >> 1), cq = 32 * (wid & 1) + r32;
  const int rs = min(max(rq - 4, 0), 120), cs = min(max(cq - 8, 0), 48);
  SLOAD(0); SWRITE(0); __syncthreads();
  for (int j = 0; j < NT; ++j) {
    const int b = j & 1;
    if (j + 1 < NT) SLOAD((j + 1) * KVBLK);
    bool active = true;
    if constexpr (!MLA) { const int R = R0 + j; active = (R >= rs) && (R < rs + 8); }
    if (active) {
      f32x16 p0 = {}, p1 = {};
      const char* Ks = lds + L_KN + b * SHM_KN;
#pragma unroll
      for (int d0 = 0; d0 < 8; ++d0) { const int cb = d0 * 32 + hi * 16;
        const bf16x8 b0 = *reinterpret_cast<const bf16x8*>(Ks + KSWZ(r32, cb));
        const bf16x8 b1 = *reinterpret_cast<const bf16x8*>(Ks + KSWZ(32 + r32, cb));
        p0 = __builtin_amdgcn_mfma_f32_32x32x16_bf16(b0, qr[d0], p0, 0, 0, 0);
        p1 = __builtin_amdgcn_mfma_f32_32x32x16_bf16(b1, qr[d0], p1, 0, 0, 0); }
      if constexpr (MLA) {
        const char* Kr = lds + L_KR + b * SHM_KR;
#pragma unroll
        for (int d0 = 0; d0 < 4; ++d0) { const int cb = d0 * 32 + hi * 16;
          const bf16x8 b0 = *reinterpret_cast<const bf16x8*>(Kr + RSWZ(r32, cb));
          const bf16x8 b1 = *reinterpret_cast<const bf16x8*>(Kr + RSWZ(32 + r32, cb));
          p0 = __builtin_amdgcn_mfma_f32_32x32x16_bf16(b0, qr[8 + d0], p0, 0, 0, 0);
          p1 = __builtin_amdgcn_mfma_f32_32x32x16_bf16(b1, qr[8 + d0], p1, 0, 0, 0); }
      } else {
        const int dr = R0 + j - rq + 7; const float* tb = tab + dr * 31 - cq + 15;
#pragma unroll
        for (int r = 0; r < 16; ++r) { const int kc = crow(r, hi);
          const float b0 = tb[kc], b1 = tb[kc + 32];
          p0[r] = ((unsigned)(kc - cs) < 16u) ? p0[r] + b0 : -INFINITY;
          p1[r] = ((unsigned)(kc + 32 - cs) < 16u) ? p1[r] + b1 : -INFINITY; }
      }
      float mn, alpha; bf16x8 pa0, pa1, pa2, pa3;
      partialSM(p0, p1, m_reg, mn, alpha, C, THRS);
      finishSM(p0, p1, alpha, l_reg, pa0, pa1, pa2, pa3);
      if (__any(alpha < 1.f)) { if (hi == 0) al_l[r32] = alpha; asm volatile("s_waitcnt lgkmcnt(0)" ::: "memory");
#pragma unroll
        for (int d = 0; d < 4; ++d)
#pragma unroll
          for (int r = 0; r < 16; ++r) o[d][r] *= al_l[crow(r, hi)]; }
      SBAR();
      pv_d0(o, vb0 + b * SHM_V, pa0, pa1, pa2, pa3);
    }
    if (j + 1 < NT) SWRITE(b ^ 1);
    __syncthreads();
  }
  if (hi == 0) li_l[r32] = l_reg; asm volatile("s_waitcnt lgkmcnt(0)" ::: "memory");
  float rli[16];
#pragma unroll
  for (int r = 0; r < 16; ++r) rli[r] = __builtin_amdgcn_rcpf(li_l[crow(r, hi)]);
  { unsigned zr[16][4];
#pragma unroll
    for (int r = 0; r < 16; ++r) { const long trow = wid * QBLK + crow(r, hi);
#pragma unroll
      for (int d0 = 0; d0 < 4; ++d0) zr[r][d0] = Zp[trow * LDZ + d0 * 32 + r32]; }
    asm volatile("s_waitcnt vmcnt(0)" ::: "memory"); SBAR();
#pragma unroll
    for (int r = 0; r < 16; ++r) { const long trow = wid * QBLK + crow(r, hi);
#pragma unroll
      for (int d0 = 0; d0 < 4; ++d0) { const float z = bf2f(zr[r][d0]); const float v = o[d0][r] * rli[r];
        const float g = v * z * __builtin_amdgcn_rcpf(1.f + __expf(-z));
        Op[trow * DM + d0 * 32 + r32] = (bf16_t)f2bf(g); } } }
  __syncthreads();
#undef SLOAD
#undef SWRITE
}
constexpr int P_V = 0, P_KN = 3 * SHM_V, P_KR = P_KN + 3 * SHM_KN, P_WS = P_KR + 3 * SHM_KR, P_END = P_WS + NW * 64 * 4;
__device__ __forceinline__ void glds16(const void* gsrc, unsigned lds_dst) { unsigned keep;
  asm volatile("s_mov_b32 %0, m0\n\ts_mov_b32 m0, %2\n\ts_nop 0\n\tglobal_load_lds_dwordx4 %1, off\n\ts_mov_b32 m0, %0" : "=&s"(keep) : "v"(gsrc), "s"(lds_dst) : "memory"); }
__device__ __forceinline__ void glds16s(const void* sbase, unsigned voff, unsigned lds_dst) { unsigned keep;
  asm volatile("s_mov_b32 %0, m0\n\ts_mov_b32 m0, %2\n\ts_nop 0\n\tglobal_load_lds_dwordx4 %1, %3\n\ts_mov_b32 m0, %0" : "=&s"(keep) : "v"(voff), "s"(lds_dst), "s"(sbase) : "memory"); }
#define WAIT_BAR(N) asm volatile("s_waitcnt vmcnt(" #N ") lgkmcnt(0)\n\ts_barrier" ::: "memory")
__device__ __forceinline__ void qkt192(f32x16& p0, f32x16& p1, const char* Ks, const char* Kr, const bf16x8* qr, int r32, int hi) {
  p0 = f32x16{}; p1 = f32x16{};
#pragma unroll
  for (int d0 = 0; d0 < 8; ++d0) { const int cb = d0 * 32 + hi * 16;
    const bf16x8 b0 = *reinterpret_cast<const bf16x8*>(Ks + KSWZ(r32, cb));
    const bf16x8 b1 = *reinterpret_cast<const bf16x8*>(Ks + KSWZ(32 + r32, cb));
    p0 = __builtin_amdgcn_mfma_f32_32x32x16_bf16(b0, qr[d0], p0, 0, 0, 0);
    p1 = __builtin_amdgcn_mfma_f32_32x32x16_bf16(b1, qr[d0], p1, 0, 0, 0); }
#pragma unroll
  for (int d0 = 0; d0 < 4; ++d0) { const int cb = d0 * 32 + hi * 16;
    const bf16x8 b0 = *reinterpret_cast<const bf16x8*>(Kr + RSWZ(r32, cb));
    const bf16x8 b1 = *reinterpret_cast<const bf16x8*>(Kr + RSWZ(32 + r32, cb));
    p0 = __builtin_amdgcn_mfma_f32_32x32x16_bf16(b0, qr[8 + d0], p0, 0, 0, 0);
    p1 = __builtin_amdgcn_mfma_f32_32x32x16_bf16(b1, qr[8 + d0], p1, 0, 0, 0); }
}


typedef short v4i16_t __attribute__((ext_vector_type(4)));
typedef __attribute__((address_space(3))) const char* lds_cptr;
__device__ __forceinline__ s16x4 vtr(lds_cptr p) { return __builtin_bit_cast(s16x4, __builtin_amdgcn_ds_read_tr16_b64_v4i16((__attribute__((address_space(3))) v4i16_t*)p)); }
#define MX3(a, b, c) __builtin_fmaxf(__builtin_fmaxf((a), (b)), (c))
__device__ __forceinline__ void qkt192n(f32x16& p0, f32x16& p1, const char* Ks, const char* Kr, const bf16x8* qr, const f32x16& negm, int r32, int hi) {
#pragma unroll
  for (int d0 = 0; d0 < 8; ++d0) { const int cb = d0 * 32 + hi * 16;
    const bf16x8 b0 = *reinterpret_cast<const bf16x8*>(Ks + KSWZ(r32, cb));
    const bf16x8 b1 = *reinterpret_cast<const bf16x8*>(Ks + KSWZ(32 + r32, cb));
    if (d0 == 0) { p0 = __builtin_amdgcn_mfma_f32_32x32x16_bf16(b0, qr[0], negm, 0, 0, 0); p1 = __builtin_amdgcn_mfma_f32_32x32x16_bf16(b1, qr[0], negm, 0, 0, 0); }
    else { p0 = __builtin_amdgcn_mfma_f32_32x32x16_bf16(b0, qr[d0], p0, 0, 0, 0); p1 = __builtin_amdgcn_mfma_f32_32x32x16_bf16(b1, qr[d0], p1, 0, 0, 0); } }
#pragma unroll
  for (int d0 = 0; d0 < 4; ++d0) { const int cb = d0 * 32 + hi * 16;
    const bf16x8 b0 = *reinterpret_cast<const bf16x8*>(Kr + RSWZ(r32, cb));
    const bf16x8 b1 = *reinterpret_cast<const bf16x8*>(Kr + RSWZ(32 + r32, cb));
    p0 = __builtin_amdgcn_mfma_f32_32x32x16_bf16(b0, qr[8 + d0], p0, 0, 0, 0);
    p1 = __builtin_amdgcn_mfma_f32_32x32x16_bf16(b1, qr[8 + d0], p1, 0, 0, 0); }
}
__device__ __forceinline__ float rowmax32(const f32x16& p0, const f32x16& p1) {
  float a = MX3(p0[0], p0[1], p1[0]), b = MX3(p0[2], p0[3], p1[1]); a = MX3(a, p1[2], p1[3]);
#pragma unroll
  for (int r = 4; r < 16; r += 4) { a = MX3(a, p0[r], p0[r + 1]); b = MX3(b, p0[r + 2], p0[r + 3]); a = MX3(a, p1[r], p1[r + 1]); b = MX3(b, p1[r + 2], p1[r + 3]); }
  float m = __builtin_fmaxf(a, b);
  auto rr = __builtin_amdgcn_permlane32_swap(__float_as_uint(m), __float_as_uint(m), false, false);
  return __builtin_fmaxf(__uint_as_float(rr[0]), __uint_as_float(rr[1]));
}
__device__ __forceinline__ void finishSMn(f32x16& p0, f32x16& p1, float& l_reg, bf16x8& pa0, bf16x8& pa1, bf16x8& pa2, bf16x8& pa3) {
#pragma unroll
  for (int r = 0; r < 16; ++r) p1[r] = __builtin_amdgcn_exp2f(p1[r]);
  float ps = 0, ps2 = 0;
#pragma unroll
  for (int r = 0; r < 16; ++r) ps += p0[r];
#pragma unroll
  for (int r = 0; r < 16; ++r) ps2 += p1[r];
  ps += ps2;
  { auto rr = __builtin_amdgcn_permlane32_swap(__float_as_uint(ps), __float_as_uint(ps), false, false);
    ps = __uint_as_float(rr[0]) + __uint_as_float(rr[1]); }
  l_reg += ps;
#define PK4(P, BASE, OUT) do { unsigned a0 = cvtpk(P[BASE + 0], P[BASE + 1]), a1 = cvtpk(P[BASE + 2], P[BASE + 3]);   \
    unsigned b0 = cvtpk(P[BASE + 4], P[BASE + 5]), b1 = cvtpk(P[BASE + 6], P[BASE + 7]);                              \
    auto r0 = __builtin_amdgcn_permlane32_swap(a0, b0, false, false); auto r1 = __builtin_amdgcn_permlane32_swap(a1, b1, false, false); \
    u32x4 w = {r0[0], r1[0], r0[1], r1[1]}; OUT = *reinterpret_cast<bf16x8*>(&w); } while (0)
  PK4(p0, 0, pa0); PK4(p0, 8, pa1); PK4(p1, 0, pa2); PK4(p1, 8, pa3);
#undef PK4
}
__device__ __forceinline__ void mla_unit(char* lds, const bf16_t* __restrict__ Qp, const bf16_t* __restrict__ Knp, const bf16_t* __restrict__ Vp,
                                         const bf16_t* __restrict__ Krp, const bf16_t* __restrict__ Zp, bf16_t* __restrict__ Op, const int NT,
                                         const float* __restrict__ cs_tab, const float* __restrict__ sn_tab, const int pos0, const bf16_t* __restrict__ Qrp,
                                         const bf16_t* nKnp, const bf16_t* nVp, const bf16_t* nKrp, const bool first, const bool has_next) {
  constexpr int LDQ = 256, LDK = 256, LDZ = 256;
  constexpr float SCALE = 0.07216878364870322f;
  constexpr float C = SCALE * 1.4426950408889634f, THRS = THR / SCALE;
  const int tid = opaque_tid(), wid = __builtin_amdgcn_readfirstlane(tid >> 6), lane = tid & 63, r32 = lane & 31, hi = lane >> 5;
  float* wsf = (float*)(lds + P_WS) + wid * 64; float* li_l = wsf; float* al_l = wsf + 32;
  const unsigned lds0 = (unsigned)(uintptr_t)lds;
  const int pk = (wid & 3) + 8 * (wid >> 2);
  const int krow_n = 4 * pk + (lane >> 4);
  const unsigned kn_off = (unsigned)(krow_n * LDK + (((lane & 15) ^ (krow_n & 15)) << 3)) * 2u;
  const int krow_r = 8 * wid + (lane >> 3);
  const unsigned kr_off = (unsigned)(krow_r * 64 + (((lane & 7) ^ ((krow_r >> 1) & 7)) << 3)) * 2u;
  const int vst_ = 2 * wid + (lane >> 5), vkk = (vst_ >> 2) * 8 + ((lane >> 2) & 7), vkey = (vkk & ~0xC) | ((vkk & 4) << 1) | ((vkk & 8) >> 1), vcol = (vst_ & 3) * 32 + (lane & 3) * 8;
  const unsigned v_off = (unsigned)(vkey * LDK + vcol) * 2u;
  const unsigned kn_dst = lds0 + P_KN + pk * 1024, kr_dst = lds0 + P_KR + wid * 1024, v_dst = lds0 + P_V + wid * 1024;
#define DMA_K(t, slot) do { const bf16_t* s_ = Knp + (long)(t) * (KVBLK * LDK); const unsigned d_ = (unsigned)__builtin_amdgcn_readfirstlane(kn_dst + (slot) * SHM_KN); \
    glds16s(s_, kn_off, d_); glds16s(s_ + 16 * LDK, kn_off, d_ + 4096); glds16s(Krp + (long)(t) * (KVBLK * 64), kr_off, (unsigned)__builtin_amdgcn_readfirstlane(kr_dst + (slot) * SHM_KR)); } while (0)
#define DMA_V(t, slot) do { const bf16_t* s_ = Vp + (long)(t) * (KVBLK * LDK); const unsigned d_ = (unsigned)__builtin_amdgcn_readfirstlane(v_dst + (slot) * SHM_V); \
    glds16s(s_, v_off, d_); glds16s(s_ + 32 * LDK, v_off, d_ + 8192); } while (0)
#define DMA_K2(KB, RB, t, slot) do { const bf16_t* s_ = (KB) + (long)(t) * (KVBLK * LDK); const unsigned d_ = (unsigned)__builtin_amdgcn_readfirstlane(kn_dst + (slot) * SHM_KN); \
    glds16s(s_, kn_off, d_); glds16s(s_ + 16 * LDK, kn_off, d_ + 4096); glds16s((RB) + (long)(t) * (KVBLK * 64), kr_off, (unsigned)__builtin_amdgcn_readfirstlane(kr_dst + (slot) * SHM_KR)); } while (0)
#define DMA_V2(VB, t, slot) do { const bf16_t* s_ = (VB) + (long)(t) * (KVBLK * LDK); const unsigned d_ = (unsigned)__builtin_amdgcn_readfirstlane(v_dst + (slot) * SHM_V); \
    glds16s(s_, v_off, d_); glds16s(s_ + 32 * LDK, v_off, d_ + 8192); } while (0)
  if (first) { DMA_K(0, 0); DMA_V(0, 0); DMA_K(1, 1); DMA_V(1, 1); DMA_K(2, 2); }
  float l_reg = 0.f; f32x16 o[4] = {}; bf16x8 qr[12];
  const bf16_t* Qw = Qp + (long)(wid * QBLK + r32) * LDQ + hi * 8;
#pragma unroll
  for (int d0 = 0; d0 < 8; ++d0) { const u32x4 raw = *reinterpret_cast<const u32x4*>(Qw + d0 * 16); u32x4 w;
#pragma unroll
    for (int p = 0; p < 4; ++p) w[p] = cvtpk(bf2f(raw[p] & 0xffffu) * C, bf2f(raw[p] >> 16) * C);
    qr[d0] = *reinterpret_cast<bf16x8*>(&w); }
  { const int pos = pos0 + wid * QBLK + r32;
#pragma unroll
    for (int d0 = 0; d0 < 4; ++d0) {
      const u32x4 raw = *reinterpret_cast<const u32x4*>(Qrp + (long)(wid * QBLK + r32) * LDQ + hi * 8 + d0 * 16);
      const int i0 = d0 * 8 + hi * 4;
      const f32x4 cc = *reinterpret_cast<const f32x4*>(cs_tab + pos * 32 + i0) * C, ss = *reinterpret_cast<const f32x4*>(sn_tab + pos * 32 + i0) * C;
      u32x4 w;
#pragma unroll
      for (int p = 0; p < 4; ++p) { const float x1 = bf2f(raw[p] & 0xffffu), x2 = bf2f(raw[p] >> 16); w[p] = cvtpk(x1 * cc[p] - x2 * ss[p], x1 * ss[p] + x2 * cc[p]); }
      qr[8 + d0] = *reinterpret_cast<bf16x8*>(&w);
    } }
  f32x16 pA0, pA1, pB0, pB1; bf16x8 pa0, pa1, pa2, pa3;
  constexpr float THRL = THR * 1.4426950408889634f;
  float mhat = 0.f; f32x16 negm = f32x16{}; asm volatile("" : "+v"(negm));
  const lds_cptr vp0 = (lds_cptr)lds + P_V + v_rd_base(lane);
  const lds_cptr kn0 = (lds_cptr)lds + P_KN, kr0 = (lds_cptr)lds + P_KR;
#define NEWMAX(P0, P1, FORCE) do { const float rm = rowmax32(P0, P1); resc = false; \
    if ((FORCE) || __builtin_expect(__any(rm > THRL), 0)) { const float dl = (FORCE) ? rm : __builtin_fmaxf(rm, 0.f); mhat += dl; \
      _Pragma("unroll") for (int r = 0; r < 16; ++r) { P0[r] -= dl; P1[r] -= dl; } \
      _Pragma("unroll") for (int r = 0; r < 16; ++r) negm[r] = -mhat; asm volatile("" : "+v"(negm)); \
      const float f = __builtin_amdgcn_exp2f(-dl); l_reg *= f; if (hi == 0) al_l[r32] = f; resc = true; } } while (0)
#define NEWMAX_TAIL(P0, P1, RM) do { resc = false; \
    if (__builtin_expect(__any((RM) > THRL), 0)) { const float dl = __builtin_fmaxf((RM), 0.f); mhat += dl; \
      _Pragma("unroll") for (int r = 0; r < 16; ++r) { P0[r] -= dl; P1[r] -= dl; } \
      _Pragma("unroll") for (int r = 0; r < 16; ++r) negm[r] = -mhat; asm volatile("" : "+v"(negm)); \
      const float f = __builtin_amdgcn_exp2f(-dl); l_reg *= f; if (hi == 0) al_l[r32] = f; resc = true; } } while (0)
#define RESC() do { if (resc) { asm volatile("s_waitcnt lgkmcnt(0)" ::: "memory"); \
    _Pragma("unroll") for (int d = 0; d < 4; ++d) _Pragma("unroll") for (int r = 0; r < 16; ++r) o[d][r] *= al_l[crow(r, hi)]; } } while (0)
#define EXP16(P) do { _Pragma("unroll") for (int r = 0; r < 16; ++r) P[r] = __builtin_amdgcn_exp2f(P[r]); } while (0)
#define PIN(x) asm volatile("" : "+v"(x))
#define LDSV(T, p) (*(const __attribute__((address_space(3))) T*)(p))
#define KLD1(G, F) do { const int D_ = (G) >> 1, W_ = (G) & 1; \
    if (D_ < 8) { F = LDSV(bf16x8, kn0 + kso + KSWZ(32 * W_ + r32, D_ * 32 + hi * 16)); } \
    else { F = LDSV(bf16x8, kr0 + kro + RSWZ(32 * W_ + r32, (D_ - 8) * 32 + hi * 16)); } } while (0)
#define VLD(H, F) do { F[0] = vtr(vp0 + vso + v_rd_off((H) & 3, (H) >> 2, 0)); F[1] = vtr(vp0 + vso + v_rd_off((H) & 3, (H) >> 2, 1)); } while (0)
#define PSWAP(A0, A1, B0, B1, OUT) do { auto r0_ = __builtin_amdgcn_permlane32_swap(A0, B0, false, false); auto r1_ = __builtin_amdgcn_permlane32_swap(A1, B1, false, false); \
    u32x4 w_ = {r0_[0], r1_[0], r0_[1], r1_[1]}; OUT = __builtin_bit_cast(bf16x8, w_); } while (0)
  bool resc = false; float sum0 = 0.f;
#define HALF0(P0) do { sum0 = 0.f; _Pragma("unroll") for (int r = 0; r < 16; ++r) sum0 += P0[r]; \
    { unsigned a0_ = cvtpk(P0[0], P0[1]), a1_ = cvtpk(P0[2], P0[3]), b0_ = cvtpk(P0[4], P0[5]), b1_ = cvtpk(P0[6], P0[7]); PSWAP(a0_, a1_, b0_, b1_, pa0); } \
    { unsigned a0_ = cvtpk(P0[8], P0[9]), a1_ = cvtpk(P0[10], P0[11]), b0_ = cvtpk(P0[12], P0[13]), b1_ = cvtpk(P0[14], P0[15]); PSWAP(a0_, a1_, b0_, b1_, pa1); } } while (0)
#define DMA_PIECE(i, j) do { \
    if ((i) < 2) { if ((j) + 2 < NT) { const bf16_t* s_ = Vp + (long)((j) + 2) * (KVBLK * LDK) + (i) * 32 * LDK; glds16s(s_, v_off, (unsigned)__builtin_amdgcn_readfirstlane(v_dst + s2 * SHM_V + (i) * 8192)); } } \
    else if ((i) < 4) { if ((j) + 3 < NT) { const bf16_t* s_ = Knp + (long)((j) + 3) * (KVBLK * LDK) + ((i) - 2) * 16 * LDK; glds16s(s_, kn_off, (unsigned)__builtin_amdgcn_readfirstlane(kn_dst + s0 * SHM_KN + ((i) - 2) * 4096)); } } \
    else { if ((j) + 3 < NT) glds16s(Krp + (long)((j) + 3) * (KVBLK * 64), kr_off, (unsigned)__builtin_amdgcn_readfirstlane(kr_dst + s0 * SHM_KR)); } } while (0)
  WAIT_BAR(10);
  qkt192n(pA0, pA1, (const char*)lds + P_KN, (const char*)lds + P_KR, qr, negm, r32, hi); NEWMAX(pA0, pA1, true); EXP16(pA0); HALF0(pA0);
  int s0 = 0, s1 = 1, s2 = 2;
#define STEP(PC0, PC1, PN0, PN1, j) do { \
    if ((j) + 2 < NT) WAIT_BAR(5); else WAIT_BAR(2); \
    const int kso = s1 * SHM_KN, kro = s1 * SHM_KR, vso = s0 * SHM_V; \
    bf16x8 kf[5]; s16x4 vf[4][2]; unsigned ca0, ca1, cb0, cb1; float sumA = sum0; \
    SBAR(); KLD1(0, kf[0]); KLD1(1, kf[1]); KLD1(2, kf[2]); KLD1(3, kf[3]); SBAR(); \
    _Pragma("unroll") for (int g = 0; g < 24; ++g) { const int d = g >> 1, w = g & 1; \
      if (g + 4 < 24) KLD1(g + 4, kf[(g + 4) % 5]); \
      if (g == 21) { VLD(0, vf[0]); } if (g == 22) { VLD(1, vf[1]); } if (g == 23) { VLD(2, vf[2]); } \
      if (w == 0) PN0 = __builtin_amdgcn_mfma_f32_32x32x16_bf16(kf[g % 5], qr[d], (d == 0) ? negm : PN0, 0, 0, 0); \
      else        PN1 = __builtin_amdgcn_mfma_f32_32x32x16_bf16(kf[g % 5], qr[d], (d == 0) ? negm : PN1, 0, 0, 0); \
      if (g < 16) { PC1[g] = __builtin_amdgcn_exp2f(PC1[g]); if (g >= 1) sumA += PC1[g - 1]; PIN(sumA); } \
      if (g == 16) { sumA += PC1[15]; PIN(sumA); } \
      if (g == 9) { ca0 = cvtpk(PC1[0], PC1[1]); ca1 = cvtpk(PC1[2], PC1[3]); } \
      if (g == 10) { cb0 = cvtpk(PC1[4], PC1[5]); cb1 = cvtpk(PC1[6], PC1[7]); } \
      if (g == 11) { PSWAP(ca0, ca1, cb0, cb1, pa2); PIN(pa2); } \
      if (g == 17) { ca0 = cvtpk(PC1[8], PC1[9]); ca1 = cvtpk(PC1[10], PC1[11]); } \
      if (g == 18) { cb0 = cvtpk(PC1[12], PC1[13]); cb1 = cvtpk(PC1[14], PC1[15]); } \
      if (g == 19) { PSWAP(ca0, ca1, cb0, cb1, pa3); PIN(pa3); } \
      if (g == 20) { auto rr_ = __builtin_amdgcn_permlane32_swap(__float_as_uint(sumA), __float_as_uint(sumA), false, false); \
                     l_reg += __uint_as_float(rr_[0]) + __uint_as_float(rr_[1]); PIN(l_reg); } \
      SBAR(); } \
    sum0 = 0.f; SBAR(); \
    _Pragma("unroll") for (int h = 0; h < 16; ++h) { \
      if (h + 3 < 16) VLD(h + 3, vf[(h + 3) & 3]); \
      if (h < 5) DMA_PIECE(h, j); \
      { const bf16x8 vb_ = (bf16x8){vf[h & 3][0][0], vf[h & 3][0][1], vf[h & 3][0][2], vf[h & 3][0][3], vf[h & 3][1][0], vf[h & 3][1][1], vf[h & 3][1][2], vf[h & 3][1][3]}; \
        const bf16x8 pa_ = (h >> 2) == 0 ? pa0 : (h >> 2) == 1 ? pa1 : (h >> 2) == 2 ? pa2 : pa3; \
        o[h & 3] = __builtin_amdgcn_mfma_f32_32x32x16_bf16(pa_, vb_, o[h & 3], 0, 0, 0); } \
      if (h >= 4 && h < 12) { PN0[2 * h - 8] = __builtin_amdgcn_exp2f(PN0[2 * h - 8]); PN0[2 * h - 7] = __builtin_amdgcn_exp2f(PN0[2 * h - 7]); if (h >= 5) { sum0 += PN0[2 * h - 10]; sum0 += PN0[2 * h - 9]; } PIN(PN0); PIN(sum0); } \
      if (h == 12) { sum0 += PN0[14]; sum0 += PN0[15]; PIN(sum0); } \
      if (h == 8) { ca0 = cvtpk(PN0[0], PN0[1]); ca1 = cvtpk(PN0[2], PN0[3]); } \
      if (h == 9) { cb0 = cvtpk(PN0[4], PN0[5]); cb1 = cvtpk(PN0[6], PN0[7]); } \
      if (h == 10) { PSWAP(ca0, ca1, cb0, cb1, pa0); PIN(pa0); } \
      if (h == 12) { ca0 = cvtpk(PN0[8], PN0[9]); ca1 = cvtpk(PN0[10], PN0[11]); } \
      if (h == 13) { cb0 = cvtpk(PN0[12], PN0[13]); cb1 = cvtpk(PN0[14], PN0[15]); } \
      if (h == 14) { PSWAP(ca0, ca1, cb0, cb1, pa1); PIN(pa1); } \
      SBAR(); \
      if (h == 3) { NEWMAX(PN0, PN1, false); SBAR(); } } \
    RESC(); { const int t_ = s0; s0 = s1; s1 = s2; s2 = t_; } } while (0)
  int j = 0;
  for (; j + 2 < NT; j += 2) { STEP(pA0, pA1, pB0, pB1, j); STEP(pB0, pB1, pA0, pA1, j + 1); }
  STEP(pA0, pA1, pB0, pB1, j);
  WAIT_BAR(0);
  { EXP16(pB1); float s_ = sum0;
#pragma unroll
    for (int r = 0; r < 16; ++r) s_ += pB1[r];
    auto rr_ = __builtin_amdgcn_permlane32_swap(__float_as_uint(s_), __float_as_uint(s_), false, false); l_reg += __uint_as_float(rr_[0]) + __uint_as_float(rr_[1]);
    { unsigned a0_ = cvtpk(pB1[0], pB1[1]), a1_ = cvtpk(pB1[2], pB1[3]), b0_ = cvtpk(pB1[4], pB1[5]), b1_ = cvtpk(pB1[6], pB1[7]); PSWAP(a0_, a1_, b0_, b1_, pa2); }
    { unsigned a0_ = cvtpk(pB1[8], pB1[9]), a1_ = cvtpk(pB1[10], pB1[11]), b0_ = cvtpk(pB1[12], pB1[13]), b1_ = cvtpk(pB1[14], pB1[15]); PSWAP(a0_, a1_, b0_, b1_, pa3); } }
  SBAR();
  pv_d0(o, (int)(lds0 + P_V) + v_rd_base(lane) + s0 * SHM_V, pa0, pa1, pa2, pa3);
  asm volatile("s_waitcnt lgkmcnt(0)\n\ts_barrier" ::: "memory");
  if (has_next) { DMA_K2(nKnp, nKrp, 0, 0); DMA_V2(nVp, 0, 0); DMA_K2(nKnp, nKrp, 1, 1); DMA_V2(nVp, 1, 1); DMA_K2(nKnp, nKrp, 2, 2); }
  if (hi == 0) li_l[r32] = l_reg; asm volatile("s_waitcnt lgkmcnt(0)" ::: "memory");
  float rli[16];
#pragma unroll
  for (int r = 0; r < 16; ++r) rli[r] = __builtin_amdgcn_rcpf(li_l[crow(r, hi)]);
  { unsigned zr[16][4];
#pragma unroll
    for (int r = 0; r < 16; ++r) { const long trow = wid * QBLK + crow(r, hi);
#pragma unroll
      for (int d0 = 0; d0 < 4; ++d0) zr[r][d0] = Zp[trow * LDZ + d0 * 32 + r32]; }
    asm volatile("s_waitcnt vmcnt(0)" ::: "memory"); SBAR();
#pragma unroll
    for (int r = 0; r < 16; ++r) { const long trow = wid * QBLK + crow(r, hi);
#pragma unroll
      for (int d0 = 0; d0 < 4; ++d0) { const float z = bf2f(zr[r][d0]); const float v = o[d0][r] * rli[r];
        const float g = v * z * __builtin_amdgcn_rcpf(1.f + __expf(-z));
        Op[trow * DM + d0 * 32 + r32] = (bf16_t)f2bf(g); } } }
  asm volatile("s_waitcnt vmcnt(0) lgkmcnt(0)\n\ts_barrier" ::: "memory");
#undef DMA_K
#undef DMA_V
#undef DMA_K2
#undef DMA_V2
#undef RESC
#undef STEP
#undef NEWMAX
#undef NEWMAX_TAIL
#undef EXP16
#undef PIN
#undef LDSV
#undef KLD1
#undef VLD
#undef PSWAP
#undef HALF0
#undef DMA_PIECE
}
#undef WAIT_BAR
#undef MX3
__device__ __forceinline__ void na_unit(char* lds, const bf16_t* __restrict__ Qp, const bf16_t* __restrict__ Knp, const bf16_t* __restrict__ Vp,
                                        const bf16_t* __restrict__ Zp, bf16_t* __restrict__ Op, const int NT, const int R0, const int r0row, const float* __restrict__ rpb_h) {
  constexpr int LDQ = NA_N, LDK = NA_N, LDZ = NA_N;
  constexpr float SCALE = 0.08838834764831845f;
  constexpr float C = SCALE * 1.4426950408889634f, THRS = THR / SCALE;
  constexpr int N_TAB = P_WS + NW * 64 * 4;
  const int tid = opaque_tid(), wid = __builtin_amdgcn_readfirstlane(tid >> 6), lane = tid & 63, r32 = lane & 31, hi = lane >> 5;
  float* wsf = (float*)(lds + P_WS) + wid * 64; float* li_l = wsf; float* al_l = wsf + 32;
  float* tab = (float*)(lds + N_TAB) + 256;
  const unsigned lds0 = (unsigned)(uintptr_t)lds;
  const int pk = (wid & 3) + 8 * (wid >> 2);
  const int krow_n = 4 * pk + (lane >> 4);
  const unsigned kn_off = (unsigned)(krow_n * LDK + (((lane & 15) ^ (krow_n & 15)) << 3)) * 2u;
  const int vst_ = 2 * wid + (lane >> 5), vkk = (vst_ >> 2) * 8 + ((lane >> 2) & 7), vkey = (vkk & ~0xC) | ((vkk & 4) << 1) | ((vkk & 8) >> 1), vcol = (vst_ & 3) * 32 + (lane & 3) * 8;
  const unsigned v_off = (unsigned)(vkey * LDK + vcol) * 2u;
  const unsigned kn_dst = lds0 + P_KN + pk * 1024, v_dst = lds0 + P_V + wid * 1024;
#define DMA_T(t, slot) do { const bf16_t* sk_ = Knp + (long)(t) * (KVBLK * LDK); const bf16_t* sv_ = Vp + (long)(t) * (KVBLK * LDK); \
    const unsigned dk_ = (unsigned)__builtin_amdgcn_readfirstlane(kn_dst + (slot) * SHM_KN), dv_ = (unsigned)__builtin_amdgcn_readfirstlane(v_dst + (slot) * SHM_V); \
    glds16s(sk_, kn_off, dk_); glds16s(sk_ + 16 * LDK, kn_off, dk_ + 4096); glds16s(sv_, v_off, dv_); glds16s(sv_ + 32 * LDK, v_off, dv_ + 8192); } while (0)
  DMA_T(0, 0); DMA_T(1, 1);
  float m_reg = -1e30f, l_reg = 0.f; f32x16 o[4] = {}; bf16x8 qr[8];
  const bf16_t* Qw = Qp + (long)(wid * QBLK + r32) * LDQ + hi * 8;
#pragma unroll
  for (int d0 = 0; d0 < 8; ++d0) qr[d0] = *reinterpret_cast<const bf16x8*>(Qw + d0 * 16);
  for (int i = tid; i < 15 * 31; i += NW * 64) tab[i] = rpb_h[i] * (1.0f / SCALE);
  const int vb0 = (int)(lds0 + P_V) + v_rd_base(lane);
  const int rq = r0row + (wid >> 1), cq = 32 * (wid & 1) + r32;
  const int rs = min(max(rq - 4, 0), 120), cs = min(max(cq - 8, 0), 48);
  int s0 = 0, s2 = 2;
  for (int j = 0; j < NT; ++j) {
    if (j + 1 < NT) asm volatile("s_waitcnt vmcnt(4) lgkmcnt(0)\n\ts_barrier" ::: "memory"); else asm volatile("s_waitcnt vmcnt(0) lgkmcnt(0)\n\ts_barrier" ::: "memory");
    if (j + 2 < NT) DMA_T(j + 2, s2);
    const int R = R0 + j;
    if ((R >= rs) && (R < rs + 8)) {
      f32x16 p0 = {}, p1 = {};
      const char* Ks = lds + P_KN + s0 * SHM_KN;
#pragma unroll
      for (int d0 = 0; d0 < 8; ++d0) { const int cb = d0 * 32 + hi * 16;
        const bf16x8 b0 = *reinterpret_cast<const bf16x8*>(Ks + KSWZ(r32, cb));
        const bf16x8 b1 = *reinterpret_cast<const bf16x8*>(Ks + KSWZ(32 + r32, cb));
        p0 = __builtin_amdgcn_mfma_f32_32x32x16_bf16(b0, qr[d0], p0, 0, 0, 0);
        p1 = __builtin_amdgcn_mfma_f32_32x32x16_bf16(b1, qr[d0], p1, 0, 0, 0); }
      { const int dr = R - rq + 7; const float* tb = tab + dr * 31 - cq + 15;
#pragma unroll
        for (int r = 0; r < 16; ++r) { const int kc = crow(r, hi);
          const float b0 = tb[kc], b1 = tb[kc + 32];
          p0[r] = ((unsigned)(kc - cs) < 16u) ? p0[r] + b0 : -INFINITY;
          p1[r] = ((unsigned)(kc + 32 - cs) < 16u) ? p1[r] + b1 : -INFINITY; } }
      float mn, alpha; bf16x8 pa0, pa1, pa2, pa3;
      partialSM(p0, p1, m_reg, mn, alpha, C, THRS);
      finishSM(p0, p1, alpha, l_reg, pa0, pa1, pa2, pa3);
      if (__any(alpha < 1.f)) { if (hi == 0) al_l[r32] = alpha; asm volatile("s_waitcnt lgkmcnt(0)" ::: "memory");
#pragma unroll
        for (int d = 0; d < 4; ++d)
#pragma unroll
          for (int r = 0; r < 16; ++r) o[d][r] *= al_l[crow(r, hi)]; }
      SBAR();
      pv_d0(o, vb0 + s0 * SHM_V, pa0, pa1, pa2, pa3);
    }
    s0 = (s0 == 2) ? 0 : s0 + 1; s2 = (s2 == 2) ? 0 : s2 + 1;
  }
  if (hi == 0) li_l[r32] = l_reg; asm volatile("s_waitcnt lgkmcnt(0)" ::: "memory");
  float rli[16];
#pragma unroll
  for (int r = 0; r < 16; ++r) rli[r] = __builtin_amdgcn_rcpf(li_l[crow(r, hi)]);
  { unsigned zr[16][4];
#pragma unroll
    for (int r = 0; r < 16; ++r) { const long trow = wid * QBLK + crow(r, hi);
#pragma unroll
      for (int d0 = 0; d0 < 4; ++d0) zr[r][d0] = Zp[trow * LDZ + d0 * 32 + r32]; }
    asm volatile("s_waitcnt vmcnt(0)" ::: "memory"); SBAR();
#pragma unroll
    for (int r = 0; r < 16; ++r) { const long trow = wid * QBLK + crow(r, hi);
#pragma unroll
      for (int d0 = 0; d0 < 4; ++d0) { const float z = bf2f(zr[r][d0]); const float v = o[d0][r] * rli[r];
        const float g = v * z * __builtin_amdgcn_rcpf(1.f + __expf(-z));
        Op[trow * DM + d0 * 32 + r32] = (bf16_t)f2bf(g); } } }
  asm volatile("s_waitcnt vmcnt(0) lgkmcnt(0)\n\ts_barrier" ::: "memory");
#undef DMA_T
}
__device__ __forceinline__ void na_unit3(char* lds, const bf16_t* __restrict__ Qp, const bf16_t* __restrict__ Knp, const bf16_t* __restrict__ Vp,
                                         const bf16_t* __restrict__ Zp, bf16_t* __restrict__ Op, const int NT, const int R0, const int r0row, const float* __restrict__ rpb_h) {
  constexpr int LDQ = 256, LDK = 256, LDZ = 256;
  constexpr float SCALE = 0.08838834764831845f;
  constexpr float C = SCALE * 1.4426950408889634f;
  constexpr float THRL = THR * 1.4426950408889634f;
  constexpr int N_V = 0, N_KN = 4 * SHM_V, N_WS = N_KN + 4 * SHM_KN, N_TAB = N_WS + NW * 64 * 4;
  const int tid = opaque_tid(), wid = __builtin_amdgcn_readfirstlane(tid >> 6), lane = tid & 63, r32 = lane & 31, hi = lane >> 5;
  float* wsf = (float*)(lds + N_WS) + wid * 64; float* li_l = wsf; float* al_l = wsf + 32;
  float* tab = (float*)(lds + N_TAB) + 256;
  const unsigned lds0 = (unsigned)(uintptr_t)lds;
  const int pk = (wid & 3) + 8 * (wid >> 2);
  const int krow_n = 4 * pk + (lane >> 4);
  const unsigned kn_off = (unsigned)(krow_n * LDK + (((lane & 15) ^ (krow_n & 15)) << 3)) * 2u;
  const int vst_ = 2 * wid + (lane >> 5), vkk = (vst_ >> 2) * 8 + ((lane >> 2) & 7), vkey = (vkk & ~0xC) | ((vkk & 4) << 1) | ((vkk & 8) >> 1), vcol = (vst_ & 3) * 32 + (lane & 3) * 8;
  const unsigned v_off = (unsigned)(vkey * LDK + vcol) * 2u;
  const unsigned kn_dst = lds0 + N_KN + pk * 1024, v_dst = lds0 + N_V + wid * 1024;
#define DMA_T(t, slot) do { const bf16_t* sk_ = Knp + (long)(t) * (KVBLK * LDK); const bf16_t* sv_ = Vp + (long)(t) * (KVBLK * LDK); \
    const unsigned dk_ = (unsigned)__builtin_amdgcn_readfirstlane(kn_dst + (slot) * SHM_KN), dv_ = (unsigned)__builtin_amdgcn_readfirstlane(v_dst + (slot) * SHM_V); \
    glds16s(sk_, kn_off, dk_); glds16s(sk_ + 16 * LDK, kn_off, dk_ + 4096); glds16s(sv_, v_off, dv_); glds16s(sv_ + 32 * LDK, v_off, dv_ + 8192); } while (0)
  DMA_T(0, 0); DMA_T(1, 1); DMA_T(2, 2);
  float l_reg = 0.f; f32x16 o[4] = {}; bf16x8 qr[8];
  const bf16_t* Qw = Qp + (long)(wid * QBLK + r32) * LDQ + hi * 8;
#pragma unroll
  for (int d0 = 0; d0 < 8; ++d0) { const u32x4 raw = *reinterpret_cast<const u32x4*>(Qw + d0 * 16); u32x4 w;
#pragma unroll
    for (int p = 0; p < 4; ++p) w[p] = cvtpk(bf2f(raw[p] & 0xffffu) * C, bf2f(raw[p] >> 16) * C);
    qr[d0] = *reinterpret_cast<bf16x8*>(&w); }
  for (int i = tid; i < 15 * 31; i += NW * 64) tab[i] = rpb_h[i] * 1.4426950408889634f;
  const int rot = 16 * (wid & 1);
  const lds_cptr vp0 = (lds_cptr)lds + N_V + v_rd_base(lane) + rot * 256; const lds_cptr kn0 = (lds_cptr)lds + N_KN;
  const int rq = r0row + (wid >> 1), cq = 32 * (wid & 1) + r32;
  const int rs = min(max(rq - 4, 0), 120), cs = min(max(cq - 8, 0), 48);
  const int t_lo = rs - R0;
  f32x16 pA0, pA1, pB0, pB1; bf16x8 pa0, pa1, pa2, pa3;
  float mhat = 0.f; f32x16 negm = f32x16{}; asm volatile("" : "+v"(negm));
  bool resc = false; float sum0 = 0.f;
#define MX3(a, b, c) __builtin_fmaxf(__builtin_fmaxf((a), (b)), (c))
#define WAIT_BAR0() asm volatile("s_waitcnt vmcnt(0) lgkmcnt(0)\n\ts_barrier" ::: "memory")
#define WAIT_BAR4() asm volatile("s_waitcnt vmcnt(4) lgkmcnt(0)\n\ts_barrier" ::: "memory")
#define NEWMAX(P0, P1, FORCE) do { float rm; { float a_ = MX3(P0[0], P0[1], P1[0]), b_ = MX3(P0[2], P0[3], P1[1]); a_ = MX3(a_, P1[2], P1[3]); \
      _Pragma("unroll") for (int r = 4; r < 16; r += 4) { a_ = MX3(a_, P0[r], P0[r + 1]); b_ = MX3(b_, P0[r + 2], P0[r + 3]); } a_ = MX3(a_, P1[4], P1[5]); b_ = MX3(b_, P1[6], P1[7]); rm = __builtin_fmaxf(a_, b_); \
      auto rr_ = __builtin_amdgcn_permlane32_swap(__float_as_uint(rm), __float_as_uint(rm), false, false); rm = __builtin_fmaxf(__uint_as_float(rr_[0]), __uint_as_float(rr_[1])); } resc = false; \
    if ((FORCE) || __builtin_expect(__any(rm > THRL), 0)) { const float dl = (FORCE) ? rm : __builtin_fmaxf(rm, 0.f); mhat += dl; \
      _Pragma("unroll") for (int r = 0; r < 16; ++r) { P0[r] -= dl; if (r < 8) P1[r] -= dl; } \
      _Pragma("unroll") for (int r = 0; r < 16; ++r) negm[r] = -mhat; asm volatile("" : "+v"(negm)); \
      const float f = __builtin_amdgcn_exp2f(-dl); l_reg *= f; if (hi == 0) al_l[r32] = f; resc = true; } } while (0)
#define RESC() do { if (resc) { asm volatile("s_waitcnt lgkmcnt(0)" ::: "memory"); \
    _Pragma("unroll") for (int d = 0; d < 4; ++d) _Pragma("unroll") for (int r = 0; r < 16; ++r) o[d][r] *= al_l[crow(r, hi)]; } } while (0)
#define EXP16(P) do { _Pragma("unroll") for (int r = 0; r < 16; ++r) P[r] = __builtin_amdgcn_exp2f(P[r]); } while (0)
#define PIN(x) asm volatile("" : "+v"(x))
#define KLDN(G, F) do { F = *(const __attribute__((address_space(3))) bf16x8*)(kn0 + kso + KSWZ(32 * ((G) & 1) + r32 + rot, ((G) >> 1) * 32 + hi * 16)); } while (0)
#define VLDN(H, F) do { F[0] = vtr(vp0 + vso + v_rd_off((H) & 3, (H) >> 2, 0)); F[1] = vtr(vp0 + vso + v_rd_off((H) & 3, (H) >> 2, 1)); } while (0)
#define PSWAP(A0, A1, B0, B1, OUT) do { auto r0_ = __builtin_amdgcn_permlane32_swap(A0, B0, false, false); auto r1_ = __builtin_amdgcn_permlane32_swap(A1, B1, false, false); \
    u32x4 w_ = {r0_[0], r1_[0], r0_[1], r1_[1]}; OUT = __builtin_bit_cast(bf16x8, w_); } while (0)
#define HALF0(P0) do { sum0 = 0.f; _Pragma("unroll") for (int r = 0; r < 16; ++r) sum0 += P0[r]; \
    { unsigned a0_ = cvtpk(P0[0], P0[1]), a1_ = cvtpk(P0[2], P0[3]), b0_ = cvtpk(P0[4], P0[5]), b1_ = cvtpk(P0[6], P0[7]); PSWAP(a0_, a1_, b0_, b1_, pa0); } \
    { unsigned a0_ = cvtpk(P0[8], P0[9]), a1_ = cvtpk(P0[10], P0[11]), b0_ = cvtpk(P0[12], P0[13]), b1_ = cvtpk(P0[14], P0[15]); PSWAP(a0_, a1_, b0_, b1_, pa1); } } while (0)
#define MASKB(P0, P1, T, ON) do { const int dr_ = R0 + (T) - rq + 7; int x_ = 4 * hi + rot - cq; asm volatile("" : "+v"(x_));     \
    const float* tb_ = tab + dr_ * 31 + 15 + x_; const int y_ = (ON) ? (x_ + cq - cs) : 4096; \
    float bb_[24];     \
    _Pragma("unroll") for (int r = 0; r < 16; ++r) bb_[r] = tb_[(r & 3) + 8 * (r >> 2)]; \
    _Pragma("unroll") for (int r = 0; r < 8; ++r) bb_[16 + r] = tb_[(r & 3) + 8 * (r >> 2) + 32]; \
    _Pragma("unroll") for (int r = 0; r < 24; ++r) asm volatile("" : "+v"(bb_[r])); \
    _Pragma("unroll") for (int r = 0; r < 16; ++r) { const int kr_ = (r & 3) + 8 * (r >> 2); \
      P0[r] = ((unsigned)(kr_ + y_) < 16u) ? P0[r] + bb_[r] : -INFINITY; if (r < 8) P1[r] = ((unsigned)(kr_ + 32 + y_) < 16u) ? P1[r] + bb_[16 + r] : -INFINITY; } } while (0)
#define QK_PLAIN(P0, P1, KSO) do { const int kso = (KSO); bf16x8 kf[5]; KLDN(0, kf[0]); KLDN(1, kf[1]); KLDN(2, kf[2]); KLDN(3, kf[3]); SBAR(); \
    _Pragma("unroll") for (int g = 0; g < 16; ++g) { const int d = g >> 1; if (g + 4 < 16) KLDN(g + 4, kf[(g + 4) % 5]); \
      if ((g & 1) == 0) P0 = __builtin_amdgcn_mfma_f32_32x32x16_bf16(kf[g % 5], qr[d], (d == 0) ? negm : P0, 0, 0, 0); \
      else              P1 = __builtin_amdgcn_mfma_f32_32x32x16_bf16(kf[g % 5], qr[d], (d == 0) ? negm : P1, 0, 0, 0); SBAR(); } } while (0)
#define PV_GAP(h) do { if ((h) + 3 < 12) VLDN((h) + 3, vf[((h) + 3) & 3]); \
      { const bf16x8 vb_ = (bf16x8){vf[(h) & 3][0][0], vf[(h) & 3][0][1], vf[(h) & 3][0][2], vf[(h) & 3][0][3], vf[(h) & 3][1][0], vf[(h) & 3][1][1], vf[(h) & 3][1][2], vf[(h) & 3][1][3]}; \
        const bf16x8 pa_ = ((h) >> 2) == 0 ? pa0 : ((h) >> 2) == 1 ? pa1 : pa2; \
        o[(h) & 3] = __builtin_amdgcn_mfma_f32_32x32x16_bf16(pa_, vb_, o[(h) & 3], 0, 0, 0); } } while (0)
#define FIN1(PC1) do { EXP16(PC1); float s_ = sum0; _Pragma("unroll") for (int r = 0; r < 16; ++r) s_ += PC1[r]; \
    auto rr_ = __builtin_amdgcn_permlane32_swap(__float_as_uint(s_), __float_as_uint(s_), false, false); l_reg += __uint_as_float(rr_[0]) + __uint_as_float(rr_[1]); \
    { unsigned a0_ = cvtpk(PC1[0], PC1[1]), a1_ = cvtpk(PC1[2], PC1[3]), b0_ = cvtpk(PC1[4], PC1[5]), b1_ = cvtpk(PC1[6], PC1[7]); PSWAP(a0_, a1_, b0_, b1_, pa2); } \
    { unsigned a0_ = cvtpk(PC1[8], PC1[9]), a1_ = cvtpk(PC1[10], PC1[11]), b0_ = cvtpk(PC1[12], PC1[13]), b1_ = cvtpk(PC1[14], PC1[15]); PSWAP(a0_, a1_, b0_, b1_, pa3); } } while (0)
#define STEP(PC0, PC1, PN0, PN1, j) do { \
    if ((j) + 2 < NT) WAIT_BAR4(); else WAIT_BAR0(); if ((j) + 3 < NT) DMA_T((j) + 3, s3); \
    const bool aC_ = ((j) >= t_lo) && ((j) < t_lo + 8), aN_ = ((j) + 1 < NT) && ((j) + 1 >= t_lo) && ((j) + 1 < t_lo + 8); \
    const int vso = s0 * SHM_V; \
    if (aC_) {     \
      const int kso = s1 * SHM_KN; bf16x8 kf[5]; s16x4 vf[4][2]; unsigned ca0, ca1, cb0, cb1; float sumA = sum0; \
      SBAR(); KLDN(0, kf[0]); KLDN(1, kf[1]); KLDN(2, kf[2]); KLDN(3, kf[3]); SBAR(); \
      _Pragma("unroll") for (int g = 0; g < 16; ++g) { const int d = g >> 1; \
        if (g + 4 < 16) KLDN(g + 4, kf[(g + 4) % 5]); \
        if (g == 13) { VLDN(0, vf[0]); } if (g == 14) { VLDN(1, vf[1]); } if (g == 15) { VLDN(2, vf[2]); } \
        if ((g & 1) == 0) PN0 = __builtin_amdgcn_mfma_f32_32x32x16_bf16(kf[g % 5], qr[d], (d == 0) ? negm : PN0, 0, 0, 0); \
        else              PN1 = __builtin_amdgcn_mfma_f32_32x32x16_bf16(kf[g % 5], qr[d], (d == 0) ? negm : PN1, 0, 0, 0); \
        if (g < 4) { PC1[2 * g] = __builtin_amdgcn_exp2f(PC1[2 * g]); PC1[2 * g + 1] = __builtin_amdgcn_exp2f(PC1[2 * g + 1]); if (g >= 1) { sumA += PC1[2 * g - 2]; sumA += PC1[2 * g - 1]; } PIN(PC1); PIN(sumA); } \
        if (g == 4) { sumA += PC1[6]; sumA += PC1[7]; PIN(sumA); } \
        if (g == 5) { ca0 = cvtpk(PC1[0], PC1[1]); ca1 = cvtpk(PC1[2], PC1[3]); } \
        if (g == 6) { cb0 = cvtpk(PC1[4], PC1[5]); cb1 = cvtpk(PC1[6], PC1[7]); } \
        if (g == 7) { PSWAP(ca0, ca1, cb0, cb1, pa2); PIN(pa2); } \
        if (g == 8) { auto rr_ = __builtin_amdgcn_permlane32_swap(__float_as_uint(sumA), __float_as_uint(sumA), false, false); \
                      l_reg += __uint_as_float(rr_[0]) + __uint_as_float(rr_[1]); PIN(l_reg); } \
        SBAR(); } \
      sum0 = 0.f; SBAR(); \
      _Pragma("unroll") for (int h = 0; h < 12; ++h) { \
        PV_GAP(h); \
        if (h >= 4 && h < 12) { PN0[2 * h - 8] = __builtin_amdgcn_exp2f(PN0[2 * h - 8]); PN0[2 * h - 7] = __builtin_amdgcn_exp2f(PN0[2 * h - 7]); if (h >= 5) { sum0 += PN0[2 * h - 10]; sum0 += PN0[2 * h - 9]; } PIN(PN0); PIN(sum0); } \
        if (h == 8) { ca0 = cvtpk(PN0[0], PN0[1]); ca1 = cvtpk(PN0[2], PN0[3]); } \
        if (h == 9) { cb0 = cvtpk(PN0[4], PN0[5]); cb1 = cvtpk(PN0[6], PN0[7]); } \
        if (h == 10) { PSWAP(ca0, ca1, cb0, cb1, pa0); PIN(pa0); } \
        SBAR(); \
        if (h == 3) { MASKB(PN0, PN1, (j) + 1, aN_); NEWMAX(PN0, PN1, false); SBAR(); } } \
      sum0 += PN0[14]; sum0 += PN0[15]; \
      ca0 = cvtpk(PN0[8], PN0[9]); ca1 = cvtpk(PN0[10], PN0[11]); cb0 = cvtpk(PN0[12], PN0[13]); cb1 = cvtpk(PN0[14], PN0[15]); PSWAP(ca0, ca1, cb0, cb1, pa1); \
      RESC(); \
    } else if (aN_) { \
      QK_PLAIN(PN0, PN1, s1 * SHM_KN); MASKB(PN0, PN1, (j) + 1, true); NEWMAX(PN0, PN1, true); EXP16(PN0); HALF0(PN0); \
    } \
    s0 = (s0 + 1) & 3; s1 = (s1 + 1) & 3; s3 = (s3 + 1) & 3; } while (0)
  int s0 = 0, s1 = 1, s3 = 3;
  WAIT_BAR4();
  if (t_lo == 0) { QK_PLAIN(pA0, pA1, 0); MASKB(pA0, pA1, 0, true); NEWMAX(pA0, pA1, true); EXP16(pA0); HALF0(pA0); }
  int j = 0;
  for (; j + 1 < NT; j += 2) { STEP(pA0, pA1, pB0, pB1, j); STEP(pB0, pB1, pA0, pA1, j + 1); }
  if (j < NT) { STEP(pA0, pA1, pB0, pB1, j); }
  if (hi == 0) li_l[r32] = l_reg; asm volatile("s_waitcnt lgkmcnt(0)" ::: "memory");
  float rli[16];
#pragma unroll
  for (int r = 0; r < 16; ++r) rli[r] = __builtin_amdgcn_rcpf(li_l[crow(r, hi)]);
  { unsigned zr[16][4];
#pragma unroll
    for (int r = 0; r < 16; ++r) { const long trow = wid * QBLK + crow(r, hi);
#pragma unroll
      for (int d0 = 0; d0 < 4; ++d0) zr[r][d0] = Zp[trow * LDZ + d0 * 32 + r32]; }
    asm volatile("s_waitcnt vmcnt(0)" ::: "memory"); SBAR();
#pragma unroll
    for (int r = 0; r < 16; ++r) { const long trow = wid * QBLK + crow(r, hi);
#pragma unroll
      for (int d0 = 0; d0 < 4; ++d0) { const float z = bf2f(zr[r][d0]); const float v = o[d0][r] * rli[r];
        const float g = v * z * __builtin_amdgcn_rcpf(1.f + __expf(-z));
        Op[trow * DM + d0 * 32 + r32] = (bf16_t)f2bf(g); } } }
  asm volatile("s_waitcnt vmcnt(0) lgkmcnt(0)\n\ts_barrier" ::: "memory");
#undef DMA_T
#undef MX3
#undef WAIT_BAR0
#undef WAIT_BAR4
#undef NEWMAX
#undef RESC
#undef EXP16
#undef PIN
#undef KLDN
#undef VLDN
#undef PSWAP
#undef HALF0
#undef MASKB
#undef QK_PLAIN
#undef PV_GAP
#undef FIN1
#undef STEP
}
#undef SBAR
}

__device__ __forceinline__ void wt_item(const float* __restrict__ W, int ldw, int K, int src_c0, bf16_t* __restrict__ WT, int dst_r0, int k0, LAS float* scr, int lane, int Ndst) {
#pragma unroll 32
    for (int i = 0; i < 32; ++i) { const int kk = 2 * i + (lane >> 5); scr[kk * 33 + (lane & 31)] = (src_c0 >= 0) ? W[(size_t)(k0 + kk) * ldw + src_c0 + (lane & 31)] : 0.f; }
    LDS_WAIT(); asm volatile("" ::: "memory");
    const int c = lane & 7;
#pragma unroll
    for (int j = 0; j < 4; ++j) { const int n = (lane >> 3) + 8 * j; const LAS float* s = scr + (8 * c) * 33 + n;
        v4u o; o.x = pk2(s[0 * 33], s[1 * 33]); o.y = pk2(s[2 * 33], s[3 * 33]); o.z = pk2(s[4 * 33], s[5 * 33]); o.w = pk2(s[6 * 33], s[7 * 33]);
        *(v4u*)(WT + ((size_t)(k0 >> 6) * Ndst + dst_r0 + n) * 64 + 8 * c) = o; }
    LDS_WAIT(); asm volatile("" ::: "memory");
}
__device__ __forceinline__ void conv_plain(const float* W, int K, int N, bf16_t* WT, LAS float* scr, int gw, int NGW, int lane) {
    const int nblk = N / 32, items = (K / 64) * nblk;
    for (int it = gw; it < items; it += NGW) { const int kb = it / nblk, nb = it % nblk; wt_item(W, N, K, nb * 32, WT, nb * 32, kb * 64, scr, lane, N); }
}
__device__ __forceinline__ void conv_mla_win(const float* W, bf16_t* WT, LAS float* scr, int gw, int NGW, int lane) {
    constexpr int nblk = MLA_NP / 32, items = (DM / 64) * nblk;
    for (int it = gw; it < items; it += NGW) { const int kb = it / nblk, nb = it % nblk;
        const int src = nb < 32 ? nb * 32 : nb < 96 ? 1088 + (nb - 32) * 32 : nb < 98 ? 1024 + (nb - 96) * 32 : -1;
        wt_item(W, 3136, DM, src, WT, nb * 32, kb * 64, scr, lane, MLA_NP); }
}
__device__ __forceinline__ void conv_generic(const float* W, int ldw, int K, int Ndst, int win_map, bf16_t* WT, LAS float* scr, int gw, int NGW, int lane) {
    const int nblk = Ndst / 32, items = (K / 64) * nblk;
    for (int it = gw; it < items; it += NGW) { const int kb = it / nblk, nb = it % nblk; int src = nb * 32;
        if (win_map == 1) src = nb < 32 ? nb * 32 : nb < 96 ? 1088 + (nb - 32) * 32 : nb < 98 ? 1024 + (nb - 96) * 32 : -1;
        if (win_map == 2) { const int n0 = nb * 32; src = n0 < 2048 ? (n0 >> 7) * 192 + (n0 & 127) : ((n0 - 2048) >> 6) * 192 + 128 + ((n0 - 2048) & 63); }
        wt_item(W, ldw, K, src, WT, nb * 32, kb * 64, scr, lane, Ndst); }
}
__device__ const double INV_FREQ[32] = {1.0, 0.7498942093324559, 0.5623413251903491, 0.4216965034285822, 0.31622776601683794, 0.23713737056616552, 0.1778279410038923, 0.1333521432163324,
    0.1, 0.07498942093324558, 0.05623413251903491, 0.042169650342858224, 0.03162277660168379, 0.023713737056616554, 0.01778279410038923, 0.01333521432163324,
    0.01, 0.007498942093324558, 0.005623413251903491, 0.004216965034285823, 0.0031622776601683794, 0.0023713737056616554, 0.0017782794100389228, 0.001333521432163324,
    0.001, 0.0007498942093324559, 0.0005623413251903491, 0.00042169650342858224, 0.00031622776601683794, 0.00023713737056616554, 0.00017782794100389227, 0.0001333521432163324};
__device__ __forceinline__ void rope_entry(int idx, float* cs, float* sn) {
    const int pos = idx >> 5, i = idx & 31;
    const double ang = (double)pos * INV_FREQ[i];
    const double k = __builtin_rint(ang * 0.15915494309189535);
    const double r = (ang - k * 6.283185307179586) - k * 2.4492935982947064e-16;
    const double r2 = r * r;
    double s = 1.0 / 51090942171709440000.0, c = 1.0 / 2432902008176640000.0;
    s = s * r2 - 1.0 / 121645100408832000.0;  c = c * r2 - 1.0 / 6402373705728000.0;
    s = s * r2 + 1.0 / 355687428096000.0;     c = c * r2 + 1.0 / 20922789888000.0;
    s = s * r2 - 1.0 / 1307674368000.0;       c = c * r2 - 1.0 / 87178291200.0;
    s = s * r2 + 1.0 / 6227020800.0;          c = c * r2 + 1.0 / 479001600.0;
    s = s * r2 - 1.0 / 39916800.0;            c = c * r2 - 1.0 / 3628800.0;
    s = s * r2 + 1.0 / 362880.0;              c = c * r2 + 1.0 / 40320.0;
    s = s * r2 - 1.0 / 5040.0;                c = c * r2 - 1.0 / 720.0;
    s = s * r2 + 1.0 / 120.0;                 c = c * r2 + 1.0 / 24.0;
    s = s * r2 - 1.0 / 6.0;                   c = c * r2 - 0.5;
    s = s * r2 + 1.0;                         c = c * r2 + 1.0;
    s = s * r;
    cs[idx] = (float)c; sn[idx] = (float)s;
}
constexpr int RPW = 2;
template <int MODE>
__device__ __forceinline__ void row_pass(const float* __restrict__ xin, float* __restrict__ xres, const bf16_t* __restrict__ y, const float* __restrict__ gpost,
                                         const float* __restrict__ gpre, bf16_t* __restrict__ h, int gw, int NGW, int lane) {
    for (int m = RPW * gw; m < M_TOK; m += RPW * NGW) {
        f32x4 xv[RPW][8]; v2u yy[RPW][8];
#pragma unroll
        for (int rr = 0; rr < RPW; ++rr) {
            const float* xr = ((MODE == 0 || xin != nullptr) ? xin : xres) + (size_t)(m + rr) * DM + lane * 4;
#pragma unroll
            for (int k = 0; k < 8; ++k) xv[rr][k] = *(const f32x4*)(xr + k * 256);
            if (MODE >= 1) { const bf16_t* yr = y + (size_t)(m + rr) * 256 + lane * 4;
#pragma unroll
                for (int k = 0; k < 8; ++k) yy[rr][k] = *(const v2u*)(yr + (size_t)k * ((size_t)M_TOK * 256)); }
        }
        if (MODE >= 1) {
            float rstd[RPW];
#pragma unroll
            for (int rr = 0; rr < RPW; ++rr) { float s = 0.f;
#pragma unroll
                for (int k = 0; k < 8; ++k)
#pragma unroll
                    for (int e = 0; e < 2; ++e) { const float a = bf2f(yy[rr][k][e] & 0xffffu), b = bf2f(yy[rr][k][e] >> 16); s += a * a + b * b; }
                rstd[rr] = 1.0f / sqrtf(wave_sum(s) * (1.f / DM) + RMS_EPS); }
#pragma unroll
            for (int k = 0; k < 8; ++k) { const f32x4 g = *(const f32x4*)(gpost + k * 256 + lane * 4);
#pragma unroll
                for (int rr = 0; rr < RPW; ++rr) { f32x4 yv;
                    yv[0] = bf2f(yy[rr][k][0] & 0xffffu); yv[1] = bf2f(yy[rr][k][0] >> 16); yv[2] = bf2f(yy[rr][k][1] & 0xffffu); yv[3] = bf2f(yy[rr][k][1] >> 16);
                    xv[rr][k] += yv * rstd[rr] * g; } }
        }
        if (MODE != 0)
#pragma unroll
        for (int rr = 0; rr < RPW; ++rr) { float* xo = xres + (size_t)(m + rr) * DM + lane * 4;
#pragma unroll
            for (int k = 0; k < 8; ++k) *(f32x4*)(xo + k * 256) = xv[rr][k]; }
        if (MODE <= 1) {
            float rstd[RPW];
#pragma unroll
            for (int rr = 0; rr < RPW; ++rr) { float s = 0.f;
#pragma unroll
                for (int k = 0; k < 8; ++k) s += (xv[rr][k][0] * xv[rr][k][0] + xv[rr][k][1] * xv[rr][k][1]) + (xv[rr][k][2] * xv[rr][k][2] + xv[rr][k][3] * xv[rr][k][3]);
                rstd[rr] = 1.0f / sqrtf(wave_sum(s) * (1.f / DM) + RMS_EPS); }
#pragma unroll
            for (int k = 0; k < 8; ++k) { const f32x4 g = *(const f32x4*)(gpre + k * 256 + lane * 4);
#pragma unroll
                for (int rr = 0; rr < RPW; ++rr) { const f32x4 a = xv[rr][k] * rstd[rr] * g;
                    v2u o; o.x = pk2(a[0], a[1]); o.y = pk2(a[2], a[3]);
                    *(v2u*)(h + (size_t)(m + rr) * DM + lane * 4 + k * 256) = o; } }
        }
    }
}
__device__ __forceinline__ void mla_mid(const bf16_t* __restrict__ wino, const float* __restrict__ gq, const float* __restrict__ gkv, const float* __restrict__ cs_tab, const float* __restrict__ sn_tab,
                                        bf16_t* __restrict__ cqn, bf16_t* __restrict__ ckvn, bf16_t* __restrict__ kr, int gw, int NGW, int lane) {
    const f32x4 gq0 = *(const f32x4*)(gq + lane * 8), gq1 = *(const f32x4*)(gq + lane * 8 + 4), gk0 = *(const f32x4*)(gkv + lane * 8), gk1 = *(const f32x4*)(gkv + lane * 8 + 4);
    for (int m0 = 4 * gw; m0 < M_TOK; m0 += 4 * NGW) {
        v4u v[4][2]; unsigned w[4]; float cc[4], ss[4];
#pragma unroll
        for (int rr = 0; rr < 4; ++rr) { const bf16_t* row = wino + (size_t)(m0 + rr) * 256; constexpr size_t TS = (size_t)M_TOK * 256;
            v[rr][0] = *(const v4u*)(row + (size_t)(lane >> 5) * TS + (lane & 31) * 8); v[rr][1] = *(const v4u*)(row + (size_t)(2 + (lane >> 5)) * TS + (lane & 31) * 8);
            w[rr] = *(const unsigned*)(row + 12 * TS + 2 * (lane & 31));
            const int pos = (m0 + rr) & (SEQ - 1); cc[rr] = cs_tab[pos * 32 + (lane & 31)]; ss[rr] = sn_tab[pos * 32 + (lane & 31)]; }
#pragma unroll
        for (int rr = 0; rr < 4; ++rr) { const int m = m0 + rr;
#pragma unroll
            for (int part = 0; part < 2; ++part) {
                float f[8]; float s = 0.f;
#pragma unroll
                for (int e = 0; e < 4; ++e) { f[2 * e] = bf2f(v[rr][part][e] & 0xffffu); f[2 * e + 1] = bf2f(v[rr][part][e] >> 16); s += f[2 * e] * f[2 * e] + f[2 * e + 1] * f[2 * e + 1]; }
                const float rstd = 1.0f / sqrtf(wave_sum(s) * (1.f / LORA) + RMS_EPS);
                const f32x4 g0 = part == 0 ? gq0 : gk0, g1 = part == 0 ? gq1 : gk1;
                v4u o; o.x = pk2(f[0] * rstd * g0[0], f[1] * rstd * g0[1]); o.y = pk2(f[2] * rstd * g0[2], f[3] * rstd * g0[3]);
                o.z = pk2(f[4] * rstd * g1[0], f[5] * rstd * g1[1]); o.w = pk2(f[6] * rstd * g1[2], f[7] * rstd * g1[3]);
                *(v4u*)((part == 0 ? cqn : ckvn) + (size_t)m * LORA + lane * 8) = o;
            }
            if (lane < 32) { const float x1 = bf2f(w[rr] & 0xffffu), x2 = bf2f(w[rr] >> 16);
                *(unsigned*)(kr + (size_t)m * 64 + 2 * lane) = pk2(x1 * cc[rr] - x2 * ss[rr], x1 * ss[rr] + x2 * cc[rr]); }
        }
    }
}

typedef __attribute__((address_space(1))) unsigned gu32;
#define XB_TMO      128
#define XB_XCNT(j)  (256  + 64 * (j))
#define XB_XSUB(j)  (1280 + 64 * (j))
#define XB_XGEN(j)  (2304 + 64 * (j))
#define XB_TOP      3328
#define XB_TOPGEN   3392
#define XCD_BAR_WORDS 3456
#define XB_SPIN_CAP (1u << 18)

__device__ __forceinline__ unsigned xb_ld(unsigned* p)              { return __hip_atomic_load(p, __ATOMIC_RELAXED, __HIP_MEMORY_SCOPE_AGENT); }
__device__ __forceinline__ unsigned xb_add(unsigned* p, unsigned v) { return __hip_atomic_fetch_add(p, v, __ATOMIC_RELAXED, __HIP_MEMORY_SCOPE_AGENT); }
__device__ __forceinline__ unsigned xb_xcc_id() { return (unsigned)__builtin_amdgcn_s_getreg((3 << 11) | 20) & 0xFu; }
#define XB_SPIN(cond, bar) do { unsigned _sp = 0; while (cond) { __builtin_amdgcn_s_sleep(1); \
    if ((++_sp & 255u) == 0u) { if (xb_ld(&(bar)[XB_TMO])) break; if (_sp > XB_SPIN_CAP) { atomicAdd(&(bar)[XB_TMO], 1u); break; } } } } while (0)

struct XcdBarrier {
    unsigned* bar; unsigned x;
    volatile LAS unsigned* st;
};

__device__ __forceinline__ XcdBarrier xcd_barrier_post(unsigned* bar, volatile LAS unsigned* st) {
    XcdBarrier b; b.bar = bar; b.x = xb_xcc_id(); b.st = st;
    if (threadIdx.x == 0) (void)xb_add(&bar[XB_XCNT(b.x)], 1u);
    return b;
}
__device__ __forceinline__ void xcd_barrier_complete(unsigned* bar, unsigned x, unsigned& nloc, unsigned& nx) {
    const unsigned G = gridDim.x * gridDim.y * gridDim.z;
    unsigned sum, cnt, mine, sp = 0u;
    for (;;) {
        sum = 0u; cnt = 0u; mine = 0u;
#pragma unroll
        for (unsigned j = 0; j < 16; ++j) { const unsigned c = xb_ld(&bar[XB_XCNT(j)]); sum += c; cnt += (c > 0u) ? 1u : 0u; mine = (j == x) ? c : mine; }
        if (sum == G) break;
        __builtin_amdgcn_s_sleep(1);
        if ((++sp & 255u) == 0u) { if (xb_ld(&bar[XB_TMO])) break; if (sp > XB_SPIN_CAP) { atomicAdd(&bar[XB_TMO], 1u); break; } }
    }
    nloc = mine > 0u ? mine : 1u; nx = cnt > 0u ? cnt : 1u;
}

__device__ __forceinline__ void xcd_barrier(const XcdBarrier& b) {
    asm volatile("s_waitcnt vmcnt(0)" ::: "memory");
    __syncthreads();
    if (threadIdx.x == 0) {
        unsigned* bar = b.bar;
        __builtin_amdgcn_s_waitcnt(0);
        unsigned nloc = b.st[0], nx = b.st[1];
        if (nloc == 0u) { xcd_barrier_complete(bar, b.x, nloc, nx); b.st[0] = nloc; b.st[1] = nx; }
        const unsigned old = xb_add(&bar[XB_XSUB(b.x)], 1u);
        const unsigned gen = old / nloc;
        if (old + 1u == (gen + 1u) * nloc) {
            __builtin_amdgcn_fence(__ATOMIC_RELEASE, "agent");
            asm volatile("s_waitcnt vmcnt(0)" ::: "memory");
            const unsigned og = xb_add(&bar[XB_TOP], 1u);
            const unsigned tg = og / nx;
            if (og + 1u == (tg + 1u) * nx) xb_add(&bar[XB_TOPGEN], 1u);
            else XB_SPIN(xb_ld(&bar[XB_TOPGEN]) == tg, bar);
            __builtin_amdgcn_fence(__ATOMIC_ACQUIRE, "agent");
            xb_add(&bar[XB_XGEN(b.x)], 1u);
            asm volatile("s_waitcnt vmcnt(0)" ::: "memory");
        } else {
            XB_SPIN(xb_ld(&bar[XB_XGEN(b.x)]) == gen, bar);
            __builtin_amdgcn_fence(__ATOMIC_ACQUIRE, "agent");
            asm volatile("s_waitcnt vmcnt(0)" ::: "memory");
        }
    }
    __syncthreads();
}

__device__ const unsigned char PH_KIND[21]  = {0, 1, 2, 1, 4,  1, 5, 1, 3, 1, 4,  1, 2, 1, 4,  1, 5, 1, 3, 1, 4};
__device__ const unsigned char PH_LAYER[21] = {0, 0, 0, 0, 0,  1, 1, 1, 1, 1, 1,  2, 2, 2, 2,  3, 3, 3, 3, 3, 3};
__device__ const unsigned char PH_SUB[21]   = {0, 0, 1, 2, 3,  0, 1, 2, 3, 4, 5,  0, 1, 2, 3,  0, 1, 2, 3, 4, 5};
constexpr int LDS_BYTES = 147456;
constexpr int NPHASES = 21;
struct Args { const float* in[12]; float* out; unsigned char* ws; int ph_lo, ph_hi; };
static_assert(sizeof(Args) == 12 * 8 + 8 + 8 + 8, "no padding");

__global__ void __launch_bounds__(NWAVES * 64, 2) fwd_mega(Args args) {
    extern __shared__ __attribute__((aligned(16))) unsigned char lds[];
    cg::grid_group grid = cg::this_grid();
    XcdBarrier bar; bar.bar = (unsigned*)args.ws; bar.x = 0; bar.st = nullptr;
    if (args.ph_hi - args.ph_lo > 2) {
        volatile LAS unsigned* MISC = (volatile LAS unsigned*)((LAS unsigned char*)lds + LDS_BYTES - 128);
        if (threadIdx.x < 32) MISC[threadIdx.x] = 0u;
        __syncthreads();
        bar = xcd_barrier_post((unsigned*)args.ws, MISC + 8);
    }
    const int G = gridDim.x, bx = blockIdx.x;
    const int vcu = (G % 8 == 0) ? (bx % 8) * (G / 8) + bx / 8 : bx;
    const int NGW = G * NWAVES;
    if (EN_PRO && args.ph_lo == 0) {
        const int tid = opaque_tid(), lane = tid & 63, wave = __builtin_amdgcn_readfirstlane(tid >> 6), gw = vcu * NWAVES + wave;
        LAS float* scr = (LAS float*)((LAS unsigned char*)lds + wave * 16384);
        unsigned char* ws = args.ws;
        const float* x_in = args.in[0]; const float* norm_pre = args.in[1];
        const float* na_w_in = args.in[3]; const float* na_w_out = args.in[5];
        const float* mla_w_in = args.in[6]; const float* mla_w_q_b = args.in[8]; const float* mla_w_kv_b = args.in[10]; const float* mla_w_out = args.in[11];
        float* xres = args.out;
        float* cs_tab = (float*)(ws + WS_COS); float* sn_tab = (float*)(ws + WS_SIN);
        bf16_t* A_WIN = (bf16_t*)(ws + WS_A_WIN); bf16_t* A_WOUT = (bf16_t*)(ws + WS_A_WOUT);
        bf16_t* B_WIN = (bf16_t*)(ws + WS_B_WIN); bf16_t* B_WIN2 = (bf16_t*)(ws + WS_B_WIN2); bf16_t* B_WQB = (bf16_t*)(ws + WS_B_WQB); bf16_t* B_WKVB = (bf16_t*)(ws + WS_B_WKVB); bf16_t* B_WOUT = (bf16_t*)(ws + WS_B_WOUT);
        bf16_t* H = (bf16_t*)(ws + WS_H);
        for (int rc_ = 0; rc_ < REP_CONV; ++rc_) {
        conv_plain(na_w_in, DM, NA_N, A_WIN, scr, gw, NGW, lane);
        conv_plain(na_w_out, DM, DM, A_WOUT, scr, gw, NGW, lane);
        conv_mla_win(mla_w_in, B_WIN, scr, gw, NGW, lane);
        conv_generic(mla_w_q_b, QB_N, LORA, QB_N, 2, B_WQB, scr, gw, NGW, lane);
        conv_plain(mla_w_kv_b, LORA, KVB_N, B_WKVB, scr, gw, NGW, lane);
        conv_plain(mla_w_out, DM, DM, B_WOUT, scr, gw, NGW, lane);
        }
        for (int i = gw * 64 + lane; i < SEQ * 32; i += NGW * 64) rope_entry(i, cs_tab, sn_tab);
        row_pass<0>(x_in, xres, nullptr, nullptr, norm_pre, H, gw, NGW, lane);
    }
    for (int ph = args.ph_lo; ph < args.ph_hi; ++ph) {
        if (ph > args.ph_lo) { for (int rs_ = 0; rs_ < REP_SYNC; ++rs_) { if (ph == args.ph_lo + 1) grid.sync(); else xcd_barrier(bar); } }
        const int tid = opaque_tid(), lane = tid & 63, wave = __builtin_amdgcn_readfirstlane(tid >> 6), gw = vcu * NWAVES + wave;
        LAS float* scr = (LAS float*)((LAS unsigned char*)lds + wave * 16384);
        int zz = 0; asm volatile("" : "+s"(zz));
        unsigned char* ws = args.ws + zz;
        const float* x_in = args.in[0 + zz]; const float* norm_pre = args.in[1 + zz]; const float* norm_post = args.in[2 + zz];
        const float* na_w_in = args.in[3 + zz]; const float* na_rpb = args.in[4 + zz]; const float* na_w_out = args.in[5 + zz];
        const float* mla_w_in = args.in[6 + zz]; const float* mla_q_norm = args.in[7 + zz]; const float* mla_w_q_b = args.in[8 + zz];
        const float* mla_kv_norm = args.in[9 + zz]; const float* mla_w_kv_b = args.in[10 + zz]; const float* mla_w_out = args.in[11 + zz];
        float* xres = args.out + zz;
        float* cs_tab = (float*)(ws + WS_COS); float* sn_tab = (float*)(ws + WS_SIN);
        bf16_t* A_WIN = (bf16_t*)(ws + WS_A_WIN); bf16_t* A_WOUT = (bf16_t*)(ws + WS_A_WOUT);
        bf16_t* B_WIN = (bf16_t*)(ws + WS_B_WIN); bf16_t* B_WIN2 = (bf16_t*)(ws + WS_B_WIN2); bf16_t* B_WQB = (bf16_t*)(ws + WS_B_WQB); bf16_t* B_WKVB = (bf16_t*)(ws + WS_B_WKVB); bf16_t* B_WOUT = (bf16_t*)(ws + WS_B_WOUT);
        bf16_t* H = (bf16_t*)(ws + WS_H); bf16_t* QKVZ = (bf16_t*)(ws + WS_QKVZ); bf16_t* WINO = (bf16_t*)(ws + WS_WINO);
        bf16_t* QB = (bf16_t*)(ws + WS_Q); bf16_t* KVB = (bf16_t*)(ws + WS_KV); bf16_t* CQN = (bf16_t*)(ws + WS_CQN); bf16_t* CKVN = (bf16_t*)(ws + WS_CKVN);
        bf16_t* KR = (bf16_t*)(ws + WS_KR); bf16_t* Y = (bf16_t*)(ws + WS_Y);

        const int kind = PH_KIND[ph], layer = PH_LAYER[ph], sub = PH_SUB[ph];
        const int jl = layer >> 1; const bool is_mla = layer & 1;
        int conv_set = -1, cgw = gw, cNGW = NGW;

        if (kind == 0) {
        } else if (EN_GEMM && kind == 1) {
            const int ng = (is_mla && sub == 2) ? 2 : 1;
            for (int gi = 0; gi < ng * REP_GEMM; ++gi) {
                const bf16_t* A; const bf16_t* Bt; bf16_t* O; int N, K;
                if (!is_mla) { if (sub == 0) { A = H; Bt = A_WIN; O = QKVZ; N = NA_N; K = DM; } else { A = H; Bt = A_WOUT; O = Y; N = DM; K = DM; } }
                else { if (sub == 0) { A = H; Bt = (layer == 3) ? B_WIN2 : B_WIN; O = WINO; N = MLA_NP; K = DM; }
                       else if (sub == 2) { if ((gi % ng) == 0) { A = CQN; Bt = B_WQB; O = QB; N = QB_N; K = LORA; } else { A = CKVN; Bt = B_WKVB; O = KVB; N = KVB_N; K = LORA; } }
                       else { A = H; Bt = B_WOUT; O = Y; N = DM; K = DM; } }
                pg8::Gemm g{A, Bt, M_TOK, N, K}; pg8::StaticOrder S; S.init(M_TOK, N, G, bx);
                const bool tm_ = true;
                pg8::EpiBf16<0> E{O, tm_ ? 256 : N, nullptr, tm_ ? 256 : 0, tm_ ? (size_t)M_TOK * 256 : (size_t)0, 1.f};
                pg8::gemm_phase<pg8::EpiBf16<0>, pg8::StaticOrder, true, true>((LAS unsigned char*)lds, g, S, E);
                if (is_mla && sub == 0) {
                    if (G != 256) conv_set = (layer == 1) ? 0 : 2;
                    else if (bx >= 64) { conv_set = (layer == 1) ? 0 : 2; cgw = (bx - 64) * NWAVES + wave; cNGW = (G - 64) * NWAVES; }
                }
            }
        } else if (EN_NA && kind == 2) {
            for (int rep = 0; rep < REP_NA; ++rep) for (int u = vcu; u < 1024; u += G) {
                const int bh = u >> 5, rg = u & 31, b = bh >> 4, h = bh & 15, r0row = rg * 4;
                const int R0 = min(max(r0row - 4, 0), 120), last = min(max(r0row - 1, 0), 120) + 7, NT = last - R0 + 1;
                const size_t tok0 = (size_t)b * SEQ + r0row * 64, key0 = (size_t)b * SEQ + R0 * 64;
                const size_t TS = (size_t)M_TOK * 256; const bf16_t* hb = QKVZ + (size_t)(h >> 1) * TS + (h & 1) * 128;
                att::na_unit3((char*)lds, hb + tok0 * 256, hb + 8 * TS + key0 * 256, hb + 16 * TS + key0 * 256,
                             hb + 24 * TS + tok0 * 256, H + tok0 * DM + h * 128, NT, R0, r0row, na_rpb + (size_t)(jl * 16 + h) * 465);
            }
        } else if (EN_MLA && kind == 3) {
            for (int rep = 0; rep < REP_MLA; ++rep) for (int u = vcu; u < 1024; u += G) {
                const int bh = u >> 5, qb = u & 31, b = bh >> 4, h = bh & 15;
                const size_t tok0 = (size_t)b * SEQ + qb * 256, key0 = (size_t)b * SEQ;
                const int un = (u + G < 1024) ? u + G : u, bhn = un >> 5; const size_t keyn = (size_t)(bhn >> 4) * SEQ; const int hn = bhn & 15;
                const size_t TS = (size_t)M_TOK * 256;
                att::mla_unit((char*)lds, QB + (size_t)(h >> 1) * TS + tok0 * 256 + (h & 1) * 128, KVB + h * TS + key0 * 256, KVB + h * TS + key0 * 256 + 128, KR + key0 * 64,
                              WINO + (size_t)(4 + (h >> 1)) * TS + tok0 * 256 + (h & 1) * 128, H + tok0 * DM + h * 128, SEQ / 64, cs_tab, sn_tab, qb * 256, QB + (size_t)(8 + (h >> 2)) * TS + tok0 * 256 + (h & 3) * 64,
                              KVB + hn * TS + keyn * 256, KVB + hn * TS + keyn * 256 + 128, KR + keyn * 64, u == vcu, u + G < 1024);
            }
        } else if (EN_ROW && kind == 4) {
            const float* gpost = norm_post + layer * DM;
            if (layer == DEPTH - 1) row_pass<2>(nullptr, xres, Y, gpost, nullptr, nullptr, gw, NGW, lane);
            else {
                row_pass<1>(layer == 0 ? x_in : nullptr, xres, Y, gpost, norm_pre + (layer + 1) * DM, H, gw, NGW, lane);
            }
        } else if (EN_MID) {
            for (int rm_ = 0; rm_ < REP_MID; ++rm_) mla_mid(WINO, mla_q_norm + jl * LORA, mla_kv_norm + jl * LORA, cs_tab, sn_tab, CQN, CKVN, KR, gw, NGW, lane);
        }
        if (conv_set >= 0) {
            const int nmat = 3;
            for (int mi = 0; mi < nmat; ++mi) {
                const float* W; bf16_t* WT; int ldw, K, Nd; int wm = 0;
                if (conv_set == 0) { if (mi == 0) { W = na_w_in + (size_t)DM * NA_N; WT = A_WIN; ldw = NA_N; K = DM; Nd = NA_N; } else if (mi == 1) { W = na_w_out + (size_t)DM * DM; WT = A_WOUT; ldw = DM; K = DM; Nd = DM; }
                                     else { W = mla_w_in + (size_t)DM * 3136; WT = B_WIN2; ldw = 3136; K = DM; Nd = MLA_NP; wm = 1; } }
                else { if (mi == 0) { W = mla_w_q_b + (size_t)LORA * QB_N; WT = B_WQB; ldw = QB_N; K = LORA; Nd = QB_N; wm = 2; }
                       else if (mi == 1) { W = mla_w_kv_b + (size_t)LORA * KVB_N; WT = B_WKVB; ldw = KVB_N; K = LORA; Nd = KVB_N; }
                       else { W = mla_w_out + (size_t)DM * DM; WT = B_WOUT; ldw = DM; K = DM; Nd = DM; } }
                conv_generic(W, ldw, K, Nd, wm, WT, scr, cgw, cNGW, lane);
            }
        }
    }
}

#ifndef MK_PER_PHASE
#define MK_PER_PHASE 0
#endif
extern "C" void kernel_launch(void* const* d_in, const int* in_sizes, int n_in, void* d_out, int out_size, void* d_ws, size_t ws_size, hipStream_t stream) {
    static int grid = 0;
    if (grid == 0) {
        if (n_in != 12 || in_sizes[0] != M_TOK * DM || out_size != M_TOK * DM || ws_size < WS_END) {
            fprintf(stderr, "kernel_launch: unexpected shapes: n_in %d in0 %d out %d ws %zu (need %zu)\n", n_in, n_in > 0 ? in_sizes[0] : -1, out_size, ws_size, (size_t)WS_END); grid = -1; return; }
        int dev = 0, cus = 0, per_cu = 0;
        hipGetDevice(&dev); hipDeviceGetAttribute(&cus, hipDeviceAttributeMultiprocessorCount, dev);
        if (hipFuncSetAttribute((const void*)fwd_mega, hipFuncAttributeMaxDynamicSharedMemorySize, LDS_BYTES) != hipSuccess) { fprintf(stderr, "kernel_launch: hipFuncSetAttribute failed\n"); grid = -1; return; }
        if (hipOccupancyMaxActiveBlocksPerMultiprocessor(&per_cu, (const void*)fwd_mega, NWAVES * 64, LDS_BYTES) != hipSuccess || per_cu < 1) { fprintf(stderr, "kernel_launch: occupancy query says %d\n", per_cu); per_cu = 1; }
        (void)hipGetLastError();
        grid = cus * per_cu;
    }
    if (grid < 0) return;
    if (hipMemsetAsync(d_ws, 0, 16384, stream) != hipSuccess) { fprintf(stderr, "kernel_launch: memset failed\n"); return; }
    Args a{};
    for (int i = 0; i < 12; ++i) a.in[i] = (const float*)d_in[i];
    a.out = (float*)d_out; a.ws = (unsigned char*)d_ws;
#if MK_PER_PHASE
    for (int ph = 0; ph < NPHASES; ++ph) {
        a.ph_lo = ph; a.ph_hi = ph + 1; void* kargs[] = {&a};
        hipError_t e = hipLaunchCooperativeKernel((const void*)fwd_mega, dim3(grid), dim3(NWAVES * 64), kargs, LDS_BYTES, stream);
        if (e != hipSuccess) { fprintf(stderr, "kernel_launch: cooperative launch (phase %d) failed: %s (grid %d)\n", ph, hipGetErrorString(e), grid); break; }
    }
#else
    a.ph_lo = 0; a.ph_hi = NPHASES; void* kargs[] = {&a};
    hipError_t e = hipLaunchCooperativeKernel((const void*)fwd_mega, dim3(grid), dim3(NWAVES * 64), kargs, LDS_BYTES, stream);
    if (e != hipSuccess) fprintf(stderr, "kernel_launch: cooperative launch failed: %s (grid %d)\n", hipGetErrorString(e), grid);
#endif
}
```
